# Optimizing an MI355X kernel written in HIP

```python
import jax, jax.numpy as jnp
from jax import lax
import numpy as np

D_MODEL = 4096
BATCH = 1
SEQ = 8192
DEPTH = 1

HGRN_HEADS = 16
HGRN_KEY_DIM = 128
HGRN_VAL_DIM = 128
HGRN_KEY_WIDTH = HGRN_HEADS * HGRN_KEY_DIM
HGRN_VAL_WIDTH = HGRN_HEADS * HGRN_VAL_DIM
CHUNK = 64
CONV_WIDTH = 2048
CONV_GROUPS = 16
CONV_K = 3
SPLIT_SIZES = (
    HGRN_KEY_WIDTH,
    HGRN_KEY_WIDTH,
    HGRN_VAL_WIDTH,
    HGRN_VAL_WIDTH,
    CONV_WIDTH,
    CONV_WIDTH,
    CONV_WIDTH,
    CONV_WIDTH,
    D_MODEL,
    D_MODEL,
)
IN_COLS = sum(SPLIT_SIZES)
EPS = 1e-6

kernel_name = "hgrn2_shortconv_gated_hybrid"


def rmsnorm(x, w):
    xf = x.astype(jnp.float32)
    y = xf * lax.rsqrt(jnp.mean(xf * xf, axis=-1, keepdims=True) + EPS)
    return (y * w.astype(jnp.float32)).astype(x.dtype)


def hgrn2_chunkwise(q, log_f, k, v):
    bsz, t_len, n_heads, dk = q.shape
    dv = v.shape[-1]
    n_chunks = t_len // CHUNK

    def to_chunks(a):
        return a.reshape(bsz, n_chunks, CHUNK, n_heads, a.shape[-1]).transpose(1, 0, 3, 2, 4)

    causal = jnp.tril(jnp.ones((CHUNK, CHUNK), dtype=bool))[:, :, None]

    def step(state, inp):
        qc, gc, kc, vc = inp
        b = jnp.cumsum(gc, axis=2)
        o_inter = jnp.einsum('bhtd,bhde->bhte', qc * jnp.exp(b), state)
        diff = b[:, :, :, None, :] - b[:, :, None, :, :]
        decay = jnp.exp(jnp.where(causal, diff, -jnp.inf))
        scores = jnp.einsum('bhtd,bhsd,bhtsd->bhts', qc, kc, decay)
        o_intra = jnp.einsum('bhts,bhse->bhte', scores, vc)
        b_last = b[:, :, -1:, :]
        state = (jnp.exp(b_last[:, :, 0, :])[..., None] * state
                 + jnp.einsum('bhsd,bhse->bhde', kc * jnp.exp(b_last - b), vc))
        return state, o_inter + o_intra

    s0 = jnp.zeros((bsz, n_heads, dk, dv), jnp.float32)
    _, o = lax.scan(step, s0, (to_chunks(q), to_chunks(log_f), to_chunks(k), to_chunks(v)))
    return o.transpose(1, 0, 3, 2, 4).reshape(bsz, t_len, n_heads, dv)


def causal_depthwise_conv(u, w):
    rhs = w.reshape(CONV_K, 1, u.shape[-1]).astype(u.dtype)
    return lax.conv_general_dilated(
        u, rhs, window_strides=(1,), padding=[(CONV_K - 1, 0)],
        dimension_numbers=('NWC', 'WIO', 'NWC'), feature_group_count=u.shape[-1])


def setup_inputs(seed: int = 0) -> dict:
    key = jax.random.key(seed)
    ks = jax.random.split(key, 12)
    f32 = jnp.float32
    x = jax.random.normal(ks[0], (BATCH, SEQ, D_MODEL), f32)
    norm_w = 1.0 + 0.02 * jax.random.normal(ks[1], (DEPTH, D_MODEL), f32)
    w_in = jax.random.normal(ks[2], (DEPTH, D_MODEL, IN_COLS), f32) * D_MODEL ** -0.5
    lb_logits = 0.5 * jax.random.normal(ks[3], (DEPTH + 1, HGRN_KEY_WIDTH), f32)
    hgrn_norm_w = 1.0 + 0.02 * jax.random.normal(ks[4], (DEPTH, HGRN_VAL_DIM), f32)
    conv_w = jax.random.normal(ks[5], (DEPTH, CONV_K, CONV_WIDTH), f32) * CONV_K ** -0.5
    w_branch_a = jax.random.normal(ks[6], (DEPTH, HGRN_VAL_WIDTH, D_MODEL), f32) * HGRN_VAL_WIDTH ** -0.5
    w_branch_b = jax.random.normal(ks[7], (DEPTH, CONV_WIDTH, D_MODEL), f32) * CONV_WIDTH ** -0.5
    gate_bias = 0.01 * jax.random.normal(ks[8], (DEPTH, 2, D_MODEL), f32)
    w_out = jax.random.normal(ks[9], (DEPTH, D_MODEL, D_MODEL), f32) * D_MODEL ** -0.5
    final_norm_w = 1.0 + 0.02 * jax.random.normal(ks[10], (D_MODEL,), f32)
    return {"x": x, "norm_w": norm_w, "w_in": w_in, "lb_logits": lb_logits,
            "hgrn_norm_w": hgrn_norm_w, "conv_w": conv_w, "w_branch_a": w_branch_a,
            "w_branch_b": w_branch_b, "gate_bias": gate_bias, "w_out": w_out,
            "final_norm_w": final_norm_w}


def reference(x, norm_w, w_in, lb_logits, hgrn_norm_w, conv_w, w_branch_a,
              w_branch_b, gate_bias, w_out, final_norm_w):
    bsz, t_len, _ = x.shape
    f32 = jnp.float32
    lower_bounds = jnp.cumsum(jax.nn.softmax(lb_logits.astype(f32), axis=0), axis=0)
    split_points = list(np.cumsum(SPLIT_SIZES)[:-1])
    h = x
    for layer in range(DEPTH):
        u = rmsnorm(h, norm_w[layer])
        proj = jnp.einsum('btd,dc->btc', u, w_in[layer])
        (a_q, a_f, a_i, a_g, c_b, c_c, c_h, c_g, g_a, g_b) = jnp.split(proj, split_points, axis=-1)

        lb = lower_bounds[layer]
        f = lb + (1.0 - lb) * jax.nn.sigmoid(a_f.astype(f32))
        log_f = jnp.log(f)
        k = 1.0 - f
        hs = (bsz, t_len, HGRN_HEADS)
        o_a = hgrn2_chunkwise(a_q.astype(f32).reshape(hs + (HGRN_KEY_DIM,)),
                              log_f.reshape(hs + (HGRN_KEY_DIM,)),
                              k.reshape(hs + (HGRN_KEY_DIM,)),
                              a_i.astype(f32).reshape(hs + (HGRN_VAL_DIM,)))
        o_a = rmsnorm(o_a, hgrn_norm_w[layer]).reshape(bsz, t_len, HGRN_VAL_WIDTH).astype(x.dtype)
        y_a = o_a * jax.nn.silu(a_g)

        conv = causal_depthwise_conv(c_c * c_h, conv_w[layer])
        y_b = (c_b * conv) * jax.nn.silu(c_g)

        z_a = jnp.einsum('btc,cd->btd', y_a, w_branch_a[layer])
        z_b = jnp.einsum('btc,cd->btd', y_b, w_branch_b[layer])
        merged = (jax.nn.sigmoid(g_a + gate_bias[layer, 0]) * z_a
                  + jax.nn.sigmoid(g_b + gate_bias[layer, 1]) * z_b)
        h = h + jnp.einsum('btd,de->bte', merged, w_out[layer])
    return rmsnorm(h, final_norm_w)
```

```cpp
#include <hip/hip_runtime.h>
#include <hip/hip_cooperative_groups.h>
#include <cstdio>
#include <cstdint>
namespace cg = cooperative_groups;

#ifndef N_LAUNCHES
#define N_LAUNCHES 1
#endif

#ifndef PHMASK
#define PHMASK 255
#endif
#ifndef ORDER_SHARED_B
#define ORDER_SHARED_B 0
#endif
#ifndef REPMASK
#define REPMASK 0
#endif
#define REP(k) for (int rep_ = 0; rep_ < (((REPMASK >> (k)) & 1) ? 2 : 1); ++rep_)
#define LAS __attribute__((address_space(3)))
typedef _Float16 h16;
typedef _Float16 h16x8 __attribute__((ext_vector_type(8)));
typedef _Float16 h16x4 __attribute__((ext_vector_type(4)));
typedef _Float16 h16x2 __attribute__((ext_vector_type(2)));
typedef short bf16x8 __attribute__((ext_vector_type(8)));
typedef float f32x4 __attribute__((ext_vector_type(4)));
typedef float f32x2 __attribute__((ext_vector_type(2)));
typedef unsigned u32x4 __attribute__((ext_vector_type(4)));
typedef unsigned u32x2 __attribute__((ext_vector_type(2)));
typedef int i32x8 __attribute__((ext_vector_type(8)));
typedef int i32x4 __attribute__((ext_vector_type(4)));

constexpr int T = 8192, D = 4096, NIN = 24576, HW = 2048, NH = 16, HD = 128, CH = 64, NCH = T / CH;
constexpr float EPS = 1e-6f;

constexpr size_t MiB = 1u << 20;
constexpr size_t WS_SSQ = 0;
constexpr size_t WS_BAR = 65536;
constexpr size_t WS_CNT = WS_BAR + 16384;
constexpr size_t WS_DN = 1 * MiB;
constexpr size_t WS_W1T = 2 * MiB;
constexpr size_t WS_WABT = WS_W1T + 192 * MiB;
constexpr size_t WS_WOT = WS_WABT + 32 * MiB;
constexpr size_t WS_U = WS_WOT + 32 * MiB;
constexpr size_t WS_PA = WS_U + 64 * MiB;
constexpr size_t WS_PG = WS_PA + 128 * MiB;
constexpr size_t WS_PP = WS_PG + 128 * MiB;
constexpr size_t WS_PGG = WS_PP + 32 * MiB;
constexpr size_t WS_YAB = WS_PGG + 32 * MiB;
constexpr size_t WS_L = WS_YAB + 64 * MiB;
constexpr size_t WS_S = WS_L + 64 * MiB;
constexpr size_t WS_MG = WS_S + 64 * MiB;
constexpr size_t WS_U8 = WS_MG + 64 * MiB;
constexpr size_t WS_W8T = WS_U8 + 32 * MiB;
constexpr size_t WS_END = WS_W8T + 32 * MiB;
constexpr float F8_SU = 8.f, F8_SW = 256.f;

constexpr int LDS_CTL = 147456;
constexpr int LDS_BYTES = LDS_CTL + 256;

__device__ __forceinline__ unsigned f2bf(float f) { unsigned u = __builtin_bit_cast(unsigned, f); return (u + 0x7fffu + ((u >> 16) & 1u)) >> 16; }
__device__ __forceinline__ unsigned pkh(float lo, float hi) { h16x2 v; v.x = (h16)lo; v.y = (h16)hi; return __builtin_bit_cast(unsigned, v); }
#ifndef GEMM_BF16
#define GEMM_BF16 1
#endif
__device__ __forceinline__ unsigned pkg(float lo, float hi) {
#if GEMM_BF16
    unsigned r; asm("v_cvt_pk_bf16_f32 %0, %1, %2" : "=v"(r) : "v"(lo), "v"(hi)); return r;
#else
    return pkh(lo, hi);
#endif
}
__device__ __forceinline__ float wave_sum(float v) {
#pragma unroll
    for (int o = 1; o < 64; o <<= 1) v += __shfl_xor(v, o);
    return v;
}
__device__ __forceinline__ int lane_id_fresh() { int t; asm volatile("v_mbcnt_lo_u32_b32 %0, -1, 0\n\tv_mbcnt_hi_u32_b32 %0, -1, %0" : "=v"(t)); return t; }
#define fresh_tid() ((wave0 << 6) | lane_id_fresh())
__device__ __forceinline__ float sigmoidf_(float x) { return __builtin_amdgcn_rcpf(1.f + __expf(-x)); }

namespace pg8 {
constexpr int BM = 256, BK = 64, HALF = 128, HTB = HALF * BK * 2, STAGE_BYTES = 8 * HTB, NXCD = 8, WGM = 8;
__host__ __device__ __forceinline__ int lds_byte(int r, int c) { const int st = (r >> 4) * 2 + (c >> 5), rr = r & 15, cc = c & 31, ob = rr * 64 + cc * 2; return st * 1024 + (ob ^ (((ob >> 9) & 1) << 5)); }
__host__ __device__ __forceinline__ void stage_rc(int b, int& R, int& C) { const int st = b / 1024, sb = b % 1024, swz = sb ^ (((sb >> 9) & 1) << 5); R = (st >> 1) * 16 + swz / 64; C = (st & 1) * 32 + (swz % 64) / 2; }
__host__ __device__ __forceinline__ int perm32(int rho) { const int n = rho >> 4, i = rho & 15; return 8 * (i >> 2) + 4 * n + (i & 3); }
__host__ __device__ __forceinline__ int tilecol(int v) { return 64 * ((v >> 5) & 3) + 32 * (v >> 7) + perm32(v & 31); }

struct Unit { int pm, pn, half; };
struct Gemm { const void* A; const void* Bt; int M, N, K, Kloop; };
struct StaticOrder {
    int nM, nN, nwg, G, c, halves, wgm;
    __device__ void init(int M, int N, int G_, int c_, int halves_ = 1, int wgm_ = WGM) { nM = M / BM; nN = N / BM; nwg = nM * nN; G = G_; c = c_; halves = halves_; wgm = wgm_; }
    __device__ bool next(int i, Unit& u) const {
        const int ti = halves == 2 ? (i >> 1) : i; u.half = halves == 2 ? (i & 1) : 0;
#if ORDER_SHARED_B
        if (G == 256 && nM == 32 && (nN & 7) == 0) {
            if (ti >= (nN >> 3)) return false;
            const int x = c & 7, j = c >> 3; u.pm = 4 * x + (j & 3); u.pn = 8 * ti + (j >> 2); return true;
        }
#endif
        const long L = (long)ti * G + c; if (L >= nwg) return false;
        int wgid = (int)L; { const int q = nwg / NXCD, r = nwg % NXCD, xcd = wgid % NXCD, off = wgid / NXCD; wgid = (xcd < r ? xcd * (q + 1) : r * (q + 1) + (xcd - r) * q) + off; }
        const int nig = wgm * nN, gid = wgid / nig, fm = gid * wgm, gsz = (nM - fm) < wgm ? (nM - fm) : wgm;
        u.pm = fm + ((wgid % nig) % gsz); u.pn = (wgid % nig) / gsz; return true;
    }
};

template <class Epi, class Sched, bool FP8 = false>
__device__ __forceinline__ void gemm_phase(LAS unsigned char* lds, const Gemm g, const Sched& S, const Epi& E, const int tid) {
    const int wid = __builtin_amdgcn_readfirstlane(tid >> 6), lane = tid & 63, wr = wid >> 2, wc = wid & 3, fr = lane & 15, fq = lane >> 4;
    const int K = g.K, nt = g.Kloop / BK;
    const size_t halfb = (size_t)g.Kloop * 2;
    const int sc8 = 0x7f7f7f7f;
    unsigned voffA[2];
#pragma unroll
    for (int i = 0; i < 2; ++i) { int R, C; stage_rc(tid * 16 + i * 8192, R, C); voffA[i] = (unsigned)(R * K + C) * 2u; }
    const size_t kstep = (size_t)(BK * 2);
    const size_t hstep = (size_t)HALF * K * 2;
    const size_t tstep = 2 * hstep;
    const unsigned ldsw = (unsigned)wid * 1024u;
    const int aoff = lds_byte(wr * 64 + fr, fq * 8), boff = lds_byte(wc * 32 + fr, fq * 8);
#define PG8_SA(b, h) (((b) * 2 + (h)) * HTB)
#define PG8_SB(b, h) ((4 + (b) * 2 + (h)) * HTB)
#define PG8_STAGE(bufoff, gbase) do { _Pragma("unroll") for (int _i = 0; _i < 2; ++_i) \
        __builtin_amdgcn_global_load_lds((const unsigned*)((const char*)(gbase) + voffA[_i]), (LAS unsigned*)(lds + (bufoff) + ldsw + _i * 8192), 16, 0, 0); } while (0)
#define PG8_LDA(dst, b, h) do { _Pragma("unroll") for (int m = 0; m < 4; ++m) _Pragma("unroll") for (int k = 0; k < 2; ++k) dst[m][k] = *(const LAS h16x8*)(lds + PG8_SA(b, h) + aoff + m * 2048 + k * 1024); } while (0)
#define PG8_LDB(dst, b, h) do { _Pragma("unroll") for (int n = 0; n < 2; ++n) _Pragma("unroll") for (int k = 0; k < 2; ++k) dst[n][k] = *(const LAS h16x8*)(lds + PG8_SB(b, h) + boff + n * 2048 + k * 1024); } while (0)
#define PG8_MMA(ai, bj, At, Bt) do { __builtin_amdgcn_s_setprio(1); _Pragma("unroll") for (int m = 0; m < 4; ++m) _Pragma("unroll") for (int n = 0; n < 2; ++n) { \
        if constexpr (FP8) { const i32x8 b8_ = __builtin_shufflevector(__builtin_bit_cast(i32x4, Bt[n][0]), __builtin_bit_cast(i32x4, Bt[n][1]), 0, 1, 2, 3, 4, 5, 6, 7); \
            const i32x8 a8_ = __builtin_shufflevector(__builtin_bit_cast(i32x4, At[m][0]), __builtin_bit_cast(i32x4, At[m][1]), 0, 1, 2, 3, 4, 5, 6, 7); \
            asm volatile("v_mfma_scale_f32_16x16x128_f8f6f4 %0, %1, %2, %0, %3, %3 op_sel_hi:[0,0,0]" : "+v"(acc[ai][bj][m][n]) : "v"(b8_), "v"(a8_), "v"(sc8)); } \
        else { _Pragma("unroll") for (int k = 0; k < 2; ++k) acc[ai][bj][m][n] = PG8_MFMA(Bt[n][k], At[m][k], acc[ai][bj][m][n]); } } \
        __builtin_amdgcn_s_setprio(0); } while (0)
#if GEMM_BF16
#define PG8_MFMA(a, b, c) __builtin_amdgcn_mfma_f32_16x16x32_bf16(__builtin_bit_cast(bf16x8, a), __builtin_bit_cast(bf16x8, b), c, 0, 0, 0)
#else
#define PG8_MFMA(a, b, c) __builtin_amdgcn_mfma_f32_16x16x32_f16(a, b, c, 0, 0, 0)
#endif
#define PG8_WAIT_V(n) asm volatile("s_waitcnt vmcnt(" #n ")" ::: "memory")
#define PG8_WAIT_L(n) asm volatile("s_waitcnt lgkmcnt(" #n ")" ::: "memory")
#define PG8_BAR __builtin_amdgcn_s_barrier()
#define PG8_SCHED __builtin_amdgcn_sched_barrier(0)
    Unit cur, nxt; int ui = 0;
    if (!S.next(0, cur)) return;
    f32x4 acc[2][2][4][2];
#pragma unroll
    for (int a = 0; a < 2; ++a)
#pragma unroll
        for (int b = 0; b < 2; ++b)
#pragma unroll
            for (int m = 0; m < 4; ++m)
#pragma unroll
                for (int n = 0; n < 2; ++n) acc[a][b][m][n] = (f32x4){0.f, 0.f, 0.f, 0.f};
    h16x8 At[4][2], B0[2][2], B1[2][2];
    const char* cA = (const char*)g.A + (size_t)cur.pm * tstep + cur.half * halfb; const char* cB = (const char*)g.Bt + (size_t)cur.pn * tstep + cur.half * halfb;
    PG8_STAGE(PG8_SB(0, 0), cB); PG8_STAGE(PG8_SB(0, 1), cB + hstep); PG8_STAGE(PG8_SA(0, 0), cA); PG8_STAGE(PG8_SA(0, 1), cA + hstep);
    if (wr == 1) PG8_BAR;
    PG8_WAIT_V(2); PG8_BAR;
    PG8_STAGE(PG8_SB(1, 0), cB + kstep); PG8_STAGE(PG8_SA(1, 0), cA + kstep); PG8_STAGE(PG8_SB(1, 1), cB + hstep + kstep);
    PG8_WAIT_V(6); PG8_BAR;
    for (;;) {
        const bool has_next = S.next(ui + 1, nxt);
        const char* nA = has_next ? (const char*)g.A + (size_t)nxt.pm * tstep + nxt.half * halfb : cA; const char* nB = has_next ? (const char*)g.Bt + (size_t)nxt.pn * tstep + nxt.half * halfb : cB;
#define PG8_KBODY(t) do { \
            const bool last = (t == nt - 2); \
            const char* a1 = cA + (size_t)(t + 1) * kstep; \
            const char* a2 = last ? nA : cA + (size_t)(t + 2) * kstep; const char* b2 = last ? nB : cB + (size_t)(t + 2) * kstep; \
            const char* a3 = a2 + kstep; const char* b3 = b2 + kstep; \
            PG8_LDB(B0, 0, 0); PG8_LDB(B1, 0, 1); PG8_SCHED; PG8_LDA(At, 0, 0); PG8_STAGE(PG8_SA(1, 1), a1 + hstep); \
            PG8_WAIT_V(8); PG8_WAIT_L(0); PG8_BAR; PG8_MMA(0, 0, At, B0); PG8_MMA(0, 1, At, B1); PG8_BAR; PG8_SCHED; \
            PG8_LDA(At, 0, 1); PG8_STAGE(PG8_SB(0, 0), b2); PG8_STAGE(PG8_SB(0, 1), b2 + hstep); PG8_STAGE(PG8_SA(0, 0), a2); \
            PG8_WAIT_V(8); PG8_WAIT_L(0); PG8_BAR; PG8_MMA(1, 0, At, B0); PG8_MMA(1, 1, At, B1); PG8_BAR; PG8_SCHED; \
            PG8_LDB(B0, 1, 0); PG8_LDB(B1, 1, 1); PG8_SCHED; PG8_LDA(At, 1, 0); PG8_STAGE(PG8_SA(0, 1), a2 + hstep); \
            PG8_WAIT_V(8); PG8_WAIT_L(0); PG8_BAR; PG8_MMA(0, 0, At, B0); PG8_MMA(0, 1, At, B1); PG8_BAR; PG8_SCHED; \
            PG8_LDA(At, 1, 1); PG8_STAGE(PG8_SB(1, 0), b3); PG8_STAGE(PG8_SB(1, 1), b3 + hstep); PG8_STAGE(PG8_SA(1, 0), a3); \
            PG8_WAIT_V(8); PG8_WAIT_L(0); PG8_BAR; PG8_MMA(1, 0, At, B0); PG8_MMA(1, 1, At, B1); PG8_BAR; PG8_SCHED; \
        } while (0)
        for (int t = 0; t < nt; t += 2) PG8_KBODY(t);
#undef PG8_KBODY
        if (wr == 0) PG8_BAR;
        if constexpr (FP8) asm volatile("s_nop 15\n\ts_nop 15" ::: "memory");
        E(acc, cur, wr, wc, fr, fq);
        if (!has_next) break;
        if (!Epi::MID || cur.half == 1)
#pragma unroll
        for (int a = 0; a < 2; ++a)
#pragma unroll
            for (int b = 0; b < 2; ++b)
#pragma unroll
                for (int m = 0; m < 4; ++m)
#pragma unroll
                    for (int n = 0; n < 2; ++n) acc[a][b][m][n] = (f32x4){0.f, 0.f, 0.f, 0.f};
        cur = nxt; cA = nA; cB = nB; ++ui;
        if (wr == 1) PG8_BAR;
    }
    PG8_WAIT_V(0);
    PG8_BAR;
#undef PG8_SA
#undef PG8_SB
#undef PG8_STAGE
#undef PG8_LDA
#undef PG8_LDB
#undef PG8_MMA
#undef PG8_MFMA
#undef PG8_WAIT_V
#undef PG8_WAIT_L
#undef PG8_BAR
#undef PG8_SCHED
}

struct EpiG1 {
    static constexpr bool MID = false;
    h16* PA; h16* PP; h16* PGG;
    __device__ __forceinline__ void operator()(const f32x4 (&acc)[2][2][4][2], const Unit& u, int wr, int wc, int fr, int fq) const {
        const int row0 = u.pm * BM + wr * 64 + fr;
        if ((u.pn & 1) == 0) {
            h16* base = PA + 256 * (u.pn >> 1) + wc * 64 + 8 * fq;
#pragma unroll
            for (int ai = 0; ai < 2; ++ai)
#pragma unroll
                for (int m = 0; m < 4; ++m) { h16* rowp = base + (size_t)(row0 + ai * HALF + m * 16) * 8192;
#pragma unroll
                    for (int bj = 0; bj < 2; ++bj) { const f32x4 v0 = acc[ai][bj][m][0], v1 = acc[ai][bj][m][1];
                        u32x4 w; w.x = pkh(v0[0], v0[1]); w.y = pkh(v0[2], v0[3]); w.z = pkh(v1[0], v1[1]); w.w = pkh(v1[2], v1[3]);
                        *(u32x4*)(rowp + bj * 32) = w; } }
        } else {
            const int ti = u.pn >> 1, c0 = 128 * (ti >> 1) + 32 * wc + 8 * fq;
            h16* dst = (ti & 1) ? PGG : PP;
#pragma unroll
            for (int ai = 0; ai < 2; ++ai)
#pragma unroll
                for (int m = 0; m < 4; ++m) { const size_t off = (size_t)(row0 + ai * HALF + m * 16) * HW + c0;
                    float o[8];
                    if (ti & 1) {
#pragma unroll
                        for (int n = 0; n < 2; ++n)
#pragma unroll
                            for (int j = 0; j < 4; ++j) { const float g = acc[ai][1][m][n][j]; o[4 * n + j] = acc[ai][0][m][n][j] * g * sigmoidf_(g); }
                    } else {
#pragma unroll
                        for (int n = 0; n < 2; ++n)
#pragma unroll
                            for (int j = 0; j < 4; ++j) o[4 * n + j] = acc[ai][0][m][n][j] * acc[ai][1][m][n][j];
                    }
                    u32x4 w; w.x = pkh(o[0], o[1]); w.y = pkh(o[2], o[3]); w.z = pkh(o[4], o[5]); w.w = pkh(o[6], o[7]);
                    *(u32x4*)(dst + off) = w; }
        }
    }
};
struct EpiGate {
    static constexpr bool MID = false;
    h16* PG; const float* gbias;
    __device__ __forceinline__ void operator()(const f32x4 (&acc)[2][2][4][2], const Unit& u, int wr, int wc, int fr, int fq) const {
        const int row0 = u.pm * BM + wr * 64 + fr;
        const int c0 = u.pn * 128 + 32 * wc + 8 * fq;
        constexpr float DS = 1.f / (F8_SU * F8_SW);
        f32x4 ba[2], bb[2];
#pragma unroll
        for (int n = 0; n < 2; ++n) { ba[n] = *(const f32x4*)(gbias + c0 + 4 * n); bb[n] = *(const f32x4*)(gbias + D + c0 + 4 * n); }
#pragma unroll
        for (int ai = 0; ai < 2; ++ai)
#pragma unroll
            for (int m = 0; m < 4; ++m) { h16* rowp = PG + (size_t)(row0 + ai * HALF + m * 16) * 8192 + c0;
                float r[8], sg[8];
#pragma unroll
                for (int n = 0; n < 2; ++n)
#pragma unroll
                    for (int j = 0; j < 4; ++j) { const float ea = __expf(-(acc[ai][0][m][n][j] * DS + ba[n][j])), eb = __expf(-(acc[ai][1][m][n][j] * DS + bb[n][j]));
                        const float pa = 1.f + ea, pb = 1.f + eb, rp = __builtin_amdgcn_rcpf(pa * pb);
                        sg[4 * n + j] = pa * rp; r[4 * n + j] = pb * pb * rp; }
                u32x4 w; w.x = pkh(r[0], r[1]); w.y = pkh(r[2], r[3]); w.z = pkh(r[4], r[5]); w.w = pkh(r[6], r[7]);
                *(u32x4*)rowp = w;
                w.x = pkh(sg[0], sg[1]); w.y = pkh(sg[2], sg[3]); w.z = pkh(sg[4], sg[5]); w.w = pkh(sg[6], sg[7]);
                *(u32x4*)(rowp + D) = w; }
    }
};
struct EpiG2 {
    static constexpr bool MID = true;
    const h16* PG; h16* MG;
    __device__ __forceinline__ void operator()(f32x4 (&acc)[2][2][4][2], const Unit& u, int wr, int wc, int fr, int fq) const {
        const int row0 = u.pm * BM + wr * 64 + fr, col0 = u.pn * BM + wc * 64 + 8 * fq;
        const h16* gbase = PG + (size_t)row0 * 8192 + col0 + (u.half == 0 ? 0 : D);
#pragma unroll
        for (int ai = 0; ai < 2; ++ai) {
            h16x8 gt[4][2];
#pragma unroll
            for (int m = 0; m < 4; ++m)
#pragma unroll
                for (int bj = 0; bj < 2; ++bj) gt[m][bj] = *(const h16x8*)(gbase + (size_t)(ai * HALF + m * 16) * 8192 + bj * 32);
            if (u.half == 0) {
#pragma unroll
                for (int m = 0; m < 4; ++m)
#pragma unroll
                    for (int bj = 0; bj < 2; ++bj)
#pragma unroll
                        for (int j = 0; j < 4; ++j) { acc[ai][bj][m][0][j] *= (float)gt[m][bj][j]; acc[ai][bj][m][1][j] *= (float)gt[m][bj][4 + j]; }
            } else {
#pragma unroll
                for (int m = 0; m < 4; ++m) { const size_t row = (size_t)(row0 + ai * HALF + m * 16);
#pragma unroll
                    for (int bj = 0; bj < 2; ++bj) { const int col = col0 + bj * 32;
                        float o[8];
#pragma unroll
                        for (int j = 0; j < 4; ++j) { o[j] = acc[ai][bj][m][0][j] * (float)gt[m][bj][j]; o[4 + j] = acc[ai][bj][m][1][j] * (float)gt[m][bj][4 + j]; }
                        u32x4 w; w.x = pkg(o[0], o[1]); w.y = pkg(o[2], o[3]); w.z = pkg(o[4], o[5]); w.w = pkg(o[6], o[7]);
                        *(u32x4*)(MG + row * D + col) = w; } }
            }
            __builtin_amdgcn_sched_barrier(0);
        }
    }
};
struct EpiG3 {
    static constexpr bool MID = false;
    const float* x; h16* HB; float* ssq; unsigned* cnt;
    __device__ __forceinline__ void operator()(const f32x4 (&acc)[2][2][4][2], const Unit& u, int wr, int wc, int fr, int fq) const {
        const int row0 = u.pm * BM + wr * 64 + fr, col0 = u.pn * BM + wc * 64 + 8 * fq;
#pragma unroll
        for (int ai = 0; ai < 2; ++ai) {
            f32x4 xv[4][2][2];
#pragma unroll
            for (int m = 0; m < 4; ++m)
#pragma unroll
                for (int bj = 0; bj < 2; ++bj) { const float* xp = x + (size_t)(row0 + ai * HALF + m * 16) * D + col0 + bj * 32; xv[m][bj][0] = *(const f32x4*)xp; xv[m][bj][1] = *(const f32x4*)(xp + 4); }
#pragma unroll
            for (int m = 0; m < 4; ++m) { const size_t row = (size_t)(row0 + ai * HALF + m * 16); float s = 0.f;
#pragma unroll
                for (int bj = 0; bj < 2; ++bj) { const size_t o = row * D + col0 + bj * 32;
                    const f32x4 h0 = xv[m][bj][0] + acc[ai][bj][m][0], h1 = xv[m][bj][1] + acc[ai][bj][m][1];
                    s += (h0[0] * h0[0] + h0[1] * h0[1]) + (h0[2] * h0[2] + h0[3] * h0[3]) + (h1[0] * h1[0] + h1[1] * h1[1]) + (h1[2] * h1[2] + h1[3] * h1[3]);
                    u32x4 w; w.x = pkh(h0[0], h0[1]); w.y = pkh(h0[2], h0[3]); w.z = pkh(h1[0], h1[1]); w.w = pkh(h1[2], h1[3]);
                    *(u32x4*)(HB + o) = w; }
                s += __shfl_xor(s, 16); s += __shfl_xor(s, 32);
                if (fq == 0) (void)__hip_atomic_fetch_add(ssq + row, s, __ATOMIC_RELAXED, __HIP_MEMORY_SCOPE_AGENT); }
        }
        asm volatile("s_waitcnt vmcnt(0)" ::: "memory");
        if (fr == 0 && fq == 0) (void)__hip_atomic_fetch_add(cnt + 64 * u.pm, 1u, __ATOMIC_RELAXED, __HIP_MEMORY_SCOPE_AGENT);
    }
};
__device__ __forceinline__ void final_tile(const Unit& u, const h16* HB, float* ssq, unsigned* cnt, const float* fnw, float* out, int tid) {
    const int lane = tid & 63, wave = tid >> 6;
    if (tid == 0) {
        unsigned sp = 0;
        while (__hip_atomic_load(cnt + 64 * u.pm, __ATOMIC_RELAXED, __HIP_MEMORY_SCOPE_AGENT) < 16u * 8u) { __builtin_amdgcn_s_sleep(1); if (++sp > (1u << 24)) break; }
        __builtin_amdgcn_fence(__ATOMIC_ACQUIRE, "agent");
        asm volatile("s_waitcnt vmcnt(0)" ::: "memory");
    }
    __syncthreads();
    const int c0 = u.pn * BM + 4 * lane;
    const f32x4 w4 = *(const f32x4*)(fnw + c0);
#pragma unroll 1
    for (int rb = wave; rb < BM; rb += 64) {
        h16x4 hv[8]; float sq[8];
#pragma unroll
        for (int q = 0; q < 8; ++q) { const size_t row = (size_t)u.pm * BM + rb + 8 * q; hv[q] = *(const h16x4*)(HB + row * D + c0); sq[q] = __hip_atomic_load(ssq + row, __ATOMIC_RELAXED, __HIP_MEMORY_SCOPE_AGENT); }
#pragma unroll
        for (int q = 0; q < 8; ++q) { const size_t row = (size_t)u.pm * BM + rb + 8 * q; const float rs = rsqrtf(sq[q] * (1.f / D) + EPS);
            f32x4 o; o[0] = (float)hv[q][0] * rs * w4[0]; o[1] = (float)hv[q][1] * rs * w4[1]; o[2] = (float)hv[q][2] * rs * w4[2]; o[3] = (float)hv[q][3] * rs * w4[3];
            *(f32x4*)(out + row * D + c0) = o; }
    }
}
}

__device__ __forceinline__ int w1_col_of(int vr) {
    const int tile = vr >> 8, v = vr & 255;
    if (tile < 64) {
        const int ti = tile >> 1;
        if ((tile & 1) == 0) return 256 * ti + pg8::tilecol(v);
        const int bj = v >> 7, vv = v & 127, ch = 128 * (ti >> 1) + (vv & ~31) + pg8::perm32(vv & 31);
        const int kind = (ti & 1) ? (bj ? 3 : 0) : (bj ? 2 : 1);
        return 8192 + kind * HW + ch;
    }
    { const int c = tile - 64, bj = v >> 7, vv = v & 127; return 16384 + bj * D + 128 * c + (vv & ~31) + pg8::perm32(vv & 31); }
}
struct TItem { const float* src; h16* dst; int N, ldk; int f8; };
struct Ptrs {
    const float *x, *norm_w, *w_in, *lb_logits, *hgrn_nw, *conv_w, *w_a, *w_b, *gate_bias, *w_out, *final_nw;
    float* out; float* ssq; float* Dn;
    h16 *W1T, *WABT, *WOT, *U, *PA, *PG, *PP, *PGG, *YAB, *L, *MG; unsigned short* S; unsigned char *U8, *W8T; unsigned* cnt;
};

__device__ __forceinline__ TItem t_decode(const Ptrs& P, int it, int lane) {
    constexpr int I_1 = (D / 64) * (NIN / 32), I_A = (HW / 64) * (D / 32), I_O = (D / 64) * (D / 32);
    const int c4 = 4 * (lane & 7), r8 = lane >> 3;
    TItem t; int r = it;
    t.f8 = 0;
    if (r < 2 * I_A + I_O) {
        const int nb = r % (D / 32), vbase = 32 * nb, col = ((vbase + c4) & ~255) + pg8::tilecol((vbase + c4) & 255);
        if (r < I_A) { const int kb = r / (D / 32); t.N = D; t.ldk = 4096; t.src = P.w_a + (size_t)(64 * kb + r8) * D + col; t.dst = P.WABT + (size_t)vbase * 4096 + 64 * kb; return t; }
        r -= I_A;
        if (r < I_A) { const int kb = r / (D / 32); t.N = D; t.ldk = 4096; t.src = P.w_b + (size_t)(64 * kb + r8) * D + col; t.dst = P.WABT + (size_t)vbase * 4096 + HW + 64 * kb; return t; }
        r -= I_A;
        { const int kb = r / (D / 32); t.N = D; t.ldk = D; t.src = P.w_out + (size_t)(64 * kb + r8) * D + col; t.dst = P.WOT + (size_t)vbase * D + 64 * kb; return t; }
    }
    r -= 2 * I_A + I_O;
    { const int nb = r % (NIN / 32), kb = r / (NIN / 32), vbase = 32 * nb;
        t.N = NIN; t.ldk = D; t.src = P.w_in + (size_t)(64 * kb + r8) * NIN + w1_col_of(vbase + c4);
        if (vbase < 16384) t.dst = P.W1T + (size_t)vbase * D + 64 * kb;
        else { t.f8 = 1; t.dst = (h16*)(P.W8T + (size_t)(vbase - 16384) * D + 64 * kb); }
        return t; }
}
__device__ __forceinline__ void t_load(const TItem& t, f32x4 (&v)[8]) {
#pragma unroll
    for (int j = 0; j < 8; ++j) v[j] = __builtin_nontemporal_load((const f32x4*)(t.src + (size_t)(8 * j) * t.N));
}
__device__ __forceinline__ void p0_prologue(const Ptrs& P, LAS unsigned char* lds, int vcu, int G, int tid) {
    const int lane = tid & 63, wave = __builtin_amdgcn_readfirstlane(tid >> 6);
    LAS float* scr = (LAS float*)(lds + wave * 16384);
    const int gw = vcu * 8 + wave, NGW = G * 8;
    constexpr int NITEMS = (D / 64) * (NIN / 32) + 2 * (HW / 64) * (D / 32) + (D / 64) * (D / 32);
    if (gw < NITEMS) {
        TItem cur = t_decode(P, gw, lane); f32x4 v[8]; t_load(cur, v);
        for (int it = gw; it < NITEMS; it += NGW) {
            const int nit = it + NGW; const bool has_n = nit < NITEMS;
            f32x4 nv[8];
            const TItem nxt = t_decode(P, has_n ? nit : it, lane); t_load(nxt, nv);
            const int c4 = 4 * (lane & 7), r8 = lane >> 3;
#pragma unroll
            for (int j = 0; j < 8; ++j) { LAS float* d = scr + (8 * j + r8) * 33 + c4; d[0] = v[j][0]; d[1] = v[j][1]; d[2] = v[j][2]; d[3] = v[j][3]; }
            asm volatile("s_waitcnt lgkmcnt(0)" ::: "memory");
            const int c = lane & 7;
            if (cur.f8) {
#pragma unroll
                for (int j = 0; j < 4; ++j) { const int n = (lane >> 3) + 8 * j; const LAS float* sp = scr + (8 * c) * 33 + n;
                    int w0 = 0, w1 = 0;
                    w0 = __builtin_amdgcn_cvt_pk_fp8_f32(sp[0 * 33] * F8_SW, sp[1 * 33] * F8_SW, w0, false); w0 = __builtin_amdgcn_cvt_pk_fp8_f32(sp[2 * 33] * F8_SW, sp[3 * 33] * F8_SW, w0, true);
                    w1 = __builtin_amdgcn_cvt_pk_fp8_f32(sp[4 * 33] * F8_SW, sp[5 * 33] * F8_SW, w1, false); w1 = __builtin_amdgcn_cvt_pk_fp8_f32(sp[6 * 33] * F8_SW, sp[7 * 33] * F8_SW, w1, true);
                    u32x2 o; o.x = (unsigned)w0; o.y = (unsigned)w1;
                    *(u32x2*)((unsigned char*)cur.dst + (size_t)n * cur.ldk + 8 * c) = o; }
            } else {
#pragma unroll
                for (int j = 0; j < 4; ++j) { const int n = (lane >> 3) + 8 * j; const LAS float* sp = scr + (8 * c) * 33 + n;
                    u32x4 o; o.x = pkg(sp[0 * 33], sp[1 * 33]); o.y = pkg(sp[2 * 33], sp[3 * 33]); o.z = pkg(sp[4 * 33], sp[5 * 33]); o.w = pkg(sp[6 * 33], sp[7 * 33]);
                    *(u32x4*)(cur.dst + (size_t)n * cur.ldk + 8 * c) = o; }
            }
            asm volatile("s_waitcnt lgkmcnt(0)" ::: "memory");
#pragma unroll
            for (int j = 0; j < 8; ++j) v[j] = nv[j];
            cur = nxt;
        }
    }
    {
        f32x4 nwv[16];
#pragma unroll
        for (int j = 0; j < 16; ++j) nwv[j] = *((const f32x4*)P.norm_w + lane + 64 * j);
#pragma nounroll
        for (int m = gw; m < T; m += NGW) {
            const f32x4* xr = (const f32x4*)(P.x + (size_t)m * D) + lane;
            f32x4 v[16]; float s = 0.f;
#pragma unroll
            for (int j = 0; j < 16; ++j) v[j] = __builtin_nontemporal_load(xr + 64 * j);
#pragma unroll
            for (int j = 0; j < 16; ++j) s += (v[j][0] * v[j][0] + v[j][1] * v[j][1]) + (v[j][2] * v[j][2] + v[j][3] * v[j][3]);
            const float rs = rsqrtf(wave_sum(s) * (1.f / D) + EPS), s8 = rs * F8_SU;
            u32x2* o = (u32x2*)(P.U + (size_t)m * D) + lane;
            unsigned* o8 = (unsigned*)(P.U8 + (size_t)m * D) + lane;
#pragma unroll
            for (int j = 0; j < 16; ++j) { const f32x4 w = nwv[j]; const float a0 = v[j][0] * w[0], a1 = v[j][1] * w[1], a2 = v[j][2] * w[2], a3 = v[j][3] * w[3];
                u32x2 q; q.x = pkg(a0 * rs, a1 * rs); q.y = pkg(a2 * rs, a3 * rs); o[64 * j] = q;
                int w8 = 0; w8 = __builtin_amdgcn_cvt_pk_fp8_f32(a0 * s8, a1 * s8, w8, false); w8 = __builtin_amdgcn_cvt_pk_fp8_f32(a2 * s8, a3 * s8, w8, true); o8[64 * j] = (unsigned)w8; }
        }
    }
    for (int i = blockIdx.x * 512 + tid; i < T; i += G * 512) P.ssq[i] = 0.f;
}

__device__ __forceinline__ bf16x8 mk_bf16x8(const float (&v)[8]) {
    u32x4 w; w.x = f2bf(v[0]) | (f2bf(v[1]) << 16); w.y = f2bf(v[2]) | (f2bf(v[3]) << 16); w.z = f2bf(v[4]) | (f2bf(v[5]) << 16); w.w = f2bf(v[6]) | (f2bf(v[7]) << 16);
    return __builtin_bit_cast(bf16x8, w);
}
__device__ __forceinline__ void load_vt(const h16* vsrc, LAS unsigned short* VT, int tid) {
#pragma unroll
    for (int rep = 0; rep < 2; ++rep) { const int cidx = tid + 512 * rep, s = cidx >> 4, ec = (cidx & 15) * 8;
        const h16x8 v = *(const h16x8*)(vsrc + (size_t)s * 8192 + ec);
#pragma unroll
        for (int x = 0; x < 8; ++x) VT[(ec + x) * 72 + s] = (unsigned short)f2bf((float)v[x]); }
}

__device__ __forceinline__ void h1_item(const Ptrs& P, LAS unsigned char* lds, int n, int h, int tid) {
    LAS unsigned short* KT = (LAS unsigned short*)lds;
    LAS unsigned short* VT = KT + 128 * 72;
    LAS float* tot = (LAS float*)(VT + 128 * 72);
    const int d = tid & 127, i = tid >> 7, lane = tid & 63, w = tid >> 6, t0 = n * CH;
    const h16* fp = P.PA + (size_t)(t0 + 16 * i) * 8192 + HW + h * HD + d;
    const float l0 = P.lb_logits[h * HD + d], l1 = P.lb_logits[HW + h * HD + d];
    const float oml = 1.f - __builtin_amdgcn_rcpf(1.f + __expf(l1 - l0));
    float kk[16], c[16], run = 0.f;
#pragma unroll
    for (int u = 0; u < 16; ++u) { const float xv = (float)fp[(size_t)u * 8192]; const float k = oml * __builtin_amdgcn_rcpf(1.f + __expf(xv)); run += __logf(1.f - k); kk[u] = k; c[u] = run; }
    tot[i * 128 + d] = run;
    load_vt(P.PA + (size_t)t0 * 8192 + 2 * HW + h * HD, VT, tid);
    __syncthreads();
    float R = 0.f;
#pragma unroll
    for (int j = 1; j < 4; ++j) if (j > i) R += tot[j * 128 + d];
    const float base = R + run;
    float v0[8], v1[8];
#pragma unroll
    for (int u = 0; u < 8; ++u) { v0[u] = kk[u] * __expf(base - c[u]); v1[u] = kk[8 + u] * __expf(base - c[8 + u]); }
    *(LAS bf16x8*)(KT + d * 72 + 16 * i) = mk_bf16x8(v0);
    *(LAS bf16x8*)(KT + d * 72 + 16 * i + 8) = mk_bf16x8(v1);
    if (i == 0) P.Dn[(size_t)(n * NH + h) * HD + d] = __expf(base);
    __syncthreads();
    f32x4 acc[8];
#pragma unroll
    for (int nn = 0; nn < 8; ++nn) acc[nn] = (f32x4){0.f, 0.f, 0.f, 0.f};
#pragma unroll
    for (int k2 = 0; k2 < 2; ++k2) {
        const bf16x8 a = *(const LAS bf16x8*)(VT + (16 * w + (lane & 15)) * 72 + 32 * k2 + 8 * (lane >> 4));
#pragma unroll
        for (int nn = 0; nn < 8; ++nn) { const bf16x8 b = *(const LAS bf16x8*)(KT + (16 * nn + (lane & 15)) * 72 + 32 * k2 + 8 * (lane >> 4));
            acc[nn] = __builtin_amdgcn_mfma_f32_16x16x32_bf16(a, b, acc[nn], 0, 0, 0); }
    }
    h16* Lp = P.L + (size_t)(n * NH + h) * (HD * HD);
#pragma unroll
    for (int nn = 0; nn < 8; ++nn)
#pragma unroll
        for (int j = 0; j < 4; ++j) Lp[(16 * w + 4 * (lane >> 4) + j) * HD + 16 * nn + (lane & 15)] = (h16)acc[nn][j];
    __syncthreads();
}

__device__ __forceinline__ void yb_phase(const Ptrs& P, int G, int tid) {
    for (int it = blockIdx.x * 512 + tid; it < (T / 8) * (HW / 8); it += G * 512) {
        const int c = (it & 255) * 8, t0 = (it >> 8) * 8;
        float w0[8], w1[8], w2[8], pm2[8], pm1[8];
#pragma unroll
        for (int q = 0; q < 2; ++q) { const f32x4 a = *(const f32x4*)(P.conv_w + c + 4 * q), b = *(const f32x4*)(P.conv_w + HW + c + 4 * q), cc = *(const f32x4*)(P.conv_w + 2 * HW + c + 4 * q);
#pragma unroll
            for (int j = 0; j < 4; ++j) { w0[4 * q + j] = a[j]; w1[4 * q + j] = b[j]; w2[4 * q + j] = cc[j]; } }
        if (t0 > 0) { const h16x8 a = *(const h16x8*)(P.PP + (size_t)(t0 - 2) * HW + c), b = *(const h16x8*)(P.PP + (size_t)(t0 - 1) * HW + c);
#pragma unroll
            for (int j = 0; j < 8; ++j) { pm2[j] = (float)a[j]; pm1[j] = (float)b[j]; } }
        else {
#pragma unroll
            for (int j = 0; j < 8; ++j) { pm2[j] = 0.f; pm1[j] = 0.f; } }
        h16x8 pcv[8], ggv[8];
#pragma unroll
        for (int r = 0; r < 8; ++r) { pcv[r] = *(const h16x8*)(P.PP + (size_t)(t0 + r) * HW + c); ggv[r] = *(const h16x8*)(P.PGG + (size_t)(t0 + r) * HW + c); }
#pragma unroll
        for (int r = 0; r < 8; ++r) {
            const h16x8 pc = pcv[r], gg = ggv[r];
            float y[8];
#pragma unroll
            for (int j = 0; j < 8; ++j) { const float pcf = (float)pc[j]; y[j] = (float)gg[j] * (w0[j] * pm2[j] + w1[j] * pm1[j] + w2[j] * pcf); pm2[j] = pm1[j]; pm1[j] = pcf; }
            u32x4 o; o.x = pkg(y[0], y[1]); o.y = pkg(y[2], y[3]); o.z = pkg(y[4], y[5]); o.w = pkg(y[6], y[7]);
            *(u32x4*)(P.YAB + (size_t)(t0 + r) * D + HW + c) = o;
        }
    }
}

__device__ __forceinline__ void h2_phase(const Ptrs& P, int G, int tid) {
    constexpr size_t SLAB = (size_t)NH * HD * HD;
    constexpr int UB = 16;
    for (int idx = blockIdx.x * 512 + tid; idx < NH * HD * (HD / 2); idx += G * 512) {
        const int d2 = idx & 63, e = (idx >> 6) & 127, h = idx >> 13;
        const size_t off = ((size_t)h * HD + e) * HD + 2 * d2;
        float s0 = 0.f, s1 = 0.f;
        for (int nb = 0; nb < NCH; nb += UB) {
            h16x2 l[UB]; f32x2 dd[UB];
#pragma unroll
            for (int q = 0; q < UB; ++q) { l[q] = *(const h16x2*)(P.L + (size_t)(nb + q) * SLAB + off); dd[q] = *(const f32x2*)(P.Dn + (size_t)((nb + q) * NH + h) * HD + 2 * d2); }
#pragma unroll
            for (int q = 0; q < UB; ++q) {
                *(unsigned*)(P.S + (size_t)(nb + q) * SLAB + off) = f2bf(s0) | (f2bf(s1) << 16);
                s0 = dd[q][0] * s0 + (float)l[q][0]; s1 = dd[q][1] * s1 + (float)l[q][1]; }
        }
    }
}

__device__ __forceinline__ unsigned short bf1(float x) { unsigned r; asm("v_cvt_pk_bf16_f32 %0, %1, %1" : "=v"(r) : "v"(x)); return (unsigned short)r; }
__device__ __forceinline__ int vt_idx(int e, int s) { return e * 72 + (s ^ (((e >> 3) & 7) << 3)); }
__device__ __forceinline__ void tile_ld(const h16* src, h16x8 (&r)[2], int tid) {
#pragma unroll
    for (int rep = 0; rep < 2; ++rep) { const int cidx = tid + 512 * rep; r[rep] = *(const h16x8*)(src + (size_t)(cidx >> 4) * 8192 + (cidx & 15) * 8); }
}
__device__ __forceinline__ void tile_st(LAS h16* dst, const h16x8 (&r)[2], int tid) {
#pragma unroll
    for (int rep = 0; rep < 2; ++rep) { const int cidx = tid + 512 * rep; *(LAS h16x8*)(dst + (cidx >> 4) * 128 + (cidx & 15) * 8) = r[rep]; }
}
__device__ __forceinline__ void vt_st(LAS unsigned short* VT, const h16x8 (&r)[2], int tid) {
#pragma unroll
    for (int rep = 0; rep < 2; ++rep) { const int cidx = tid + 512 * rep, sI = cidx >> 4, ec = (cidx & 15) * 8;
#pragma unroll
        for (int x = 0; x < 8; ++x) VT[vt_idx(ec + x, sI)] = bf1((float)r[rep][x]); }
}

__device__ __forceinline__ float row16_sum(float v) {
    v += __builtin_bit_cast(float, __builtin_amdgcn_mov_dpp(__builtin_bit_cast(int, v), 0xB1, 0xF, 0xF, true));
    v += __builtin_bit_cast(float, __builtin_amdgcn_mov_dpp(__builtin_bit_cast(int, v), 0x4E, 0xF, 0xF, true));
    v += __builtin_bit_cast(float, __builtin_amdgcn_mov_dpp(__builtin_bit_cast(int, v), 0x141, 0xF, 0xF, true));
    v += __builtin_bit_cast(float, __builtin_amdgcn_mov_dpp(__builtin_bit_cast(int, v), 0x140, 0xF, 0xF, true));
    return v;
}
__device__ __forceinline__ void h1_phase(const Ptrs& P, LAS unsigned char* lds, int bx, int G, int tid) {
    LAS unsigned short* KT = (LAS unsigned short*)lds;
    LAS unsigned short* VT = KT + 128 * 72;
    LAS float* tot = (LAS float*)(VT + 128 * 72);
    LAS h16* FST = (LAS h16*)(tot + 512);
    LAS h16* LT = FST + 64 * 128;
    const int d = tid & 127, i = __builtin_amdgcn_readfirstlane(tid >> 7), lane = tid & 63, w = __builtin_amdgcn_readfirstlane(tid >> 6);
    const int fr = lane & 15, fq = lane >> 4;
    const int NIT = NCH * NH;
    if (bx >= NIT) return;
    h16x8 pf[2], pv[2];
#define H1_PREFETCH(itn) do { const int n_ = (itn) >> 4, h_ = (itn) & 15; const h16* base_ = P.PA + (size_t)(n_ * CH) * 8192 + h_ * HD; \
        tile_ld(base_ + HW, pf, tid); tile_ld(base_ + 2 * HW, pv, tid); } while (0)
#define H1_FLUSH(itp) do { h16* Lp_ = P.L + (size_t)(itp) * (HD * HD); \
        _Pragma("unroll") for (int rep = 0; rep < 4; ++rep) { const int cidx = tid + 512 * rep; *(h16x8*)(Lp_ + cidx * 8) = *(const LAS h16x8*)(LT + cidx * 8); } } while (0)
    H1_PREFETCH(bx);
    const bool hfix = (G & 15) == 0;
    float l0 = P.lb_logits[(bx & 15) * HD + d], l1 = P.lb_logits[HW + (bx & 15) * HD + d];
    int itprev = -1;
    for (int it = bx; it < NIT; it += G) {
        const int n = it >> 4, h = it & 15;
        if (!hfix) { l0 = P.lb_logits[h * HD + d]; l1 = P.lb_logits[HW + h * HD + d]; }
        tile_st(FST, pf, tid); vt_st(VT, pv, tid);
        __syncthreads();
        const float oml = 1.f - __builtin_amdgcn_rcpf(1.f + __expf(l1 - l0));
        float kk[16], pc[16], run = 1.f;
#pragma unroll
        for (int u = 0; u < 16; ++u) { const float xv = (float)FST[(16 * i + u) * 128 + d]; const float k = oml * __builtin_amdgcn_rcpf(1.f + __expf(xv)); run *= (1.f - k); kk[u] = k; pc[u] = run; }
        tot[i * 128 + d] = run;
        __syncthreads();
        float base = run;
#pragma unroll
        for (int j = 1; j < 4; ++j) if (j > i) base *= tot[j * 128 + d];
        float v0[8], v1[8];
#pragma unroll
        for (int u = 0; u < 8; ++u) { v0[u] = kk[u] * base * __builtin_amdgcn_rcpf(pc[u]); v1[u] = kk[8 + u] * base * __builtin_amdgcn_rcpf(pc[8 + u]); }
        *(LAS bf16x8*)(KT + d * 72 + 16 * i) = mk_bf16x8(v0);
        *(LAS bf16x8*)(KT + d * 72 + 16 * i + 8) = mk_bf16x8(v1);
        if (i == 0) P.Dn[(size_t)it * HD + d] = base;
        if (itprev >= 0) H1_FLUSH(itprev);
        { const int nit = it + G; H1_PREFETCH(nit < NIT ? nit : it); }
        __syncthreads();
        f32x4 acc[8];
#pragma unroll
        for (int nn = 0; nn < 8; ++nn) acc[nn] = (f32x4){0.f, 0.f, 0.f, 0.f};
#pragma unroll
        for (int k2 = 0; k2 < 2; ++k2) {
            const bf16x8 a = *(const LAS bf16x8*)(VT + vt_idx(16 * w + fr, 32 * k2 + 8 * fq));
#pragma unroll
            for (int nn = 0; nn < 8; ++nn) { const bf16x8 b = *(const LAS bf16x8*)(KT + (16 * nn + fr) * 72 + 32 * k2 + 8 * fq);
                acc[nn] = __builtin_amdgcn_mfma_f32_16x16x32_bf16(a, b, acc[nn], 0, 0, 0); }
        }
#pragma unroll
        for (int nn = 0; nn < 8; ++nn)
#pragma unroll
            for (int j = 0; j < 4; ++j) LT[(16 * w + 4 * fq + j) * HD + 16 * nn + fr] = (h16)acc[nn][j];
        itprev = it;
        __syncthreads();
    }
    if (itprev >= 0) H1_FLUSH(itprev);
#undef H1_PREFETCH
#undef H1_FLUSH
}

__device__ __forceinline__ void h3_phase(const Ptrs& P, LAS unsigned char* lds, int bx, int G, int tid) {
    constexpr int QS = 136;
    LAS unsigned short* Q1 = (LAS unsigned short*)lds;
    LAS unsigned short* Q2 = Q1 + 64 * QS;
    LAS unsigned short* KH = Q2 + 64 * QS;
    LAS h16* FST = (LAS h16*)KH;
    LAS h16* QST = FST + 64 * 128;
    LAS unsigned short* Pm = KH + 160 * QS;
    LAS unsigned short* VT = Pm + 64 * 72;
    LAS float* tot = (LAS float*)(VT + 128 * 72);
    LAS float* red = tot + 512;
    LAS h16* GST = (LAS h16*)(red + 512);
    LAS unsigned short* YST = (LAS unsigned short*)(GST + 64 * 128);
    const int d = tid & 127, i = __builtin_amdgcn_readfirstlane(tid >> 7), lane = tid & 63, w = __builtin_amdgcn_readfirstlane(tid >> 6);
    const int fr = lane & 15, fq = lane >> 4;
    const int NIT = NCH * NH;
    if (bx >= NIT) return;
    h16x8 pf[2], pq[2], pv[2], pg[2]; bf16x8 psb[4];
#define H3_PREFETCH(itn) do { const int n_ = (itn) >> 4, h_ = (itn) & 15; const h16* base_ = P.PA + (size_t)(n_ * CH) * 8192 + h_ * HD; \
        tile_ld(base_, pq, tid); tile_ld(base_ + HW, pf, tid); tile_ld(base_ + 2 * HW, pv, tid); tile_ld(base_ + 3 * HW, pg, tid); \
        const unsigned short* Sp_ = P.S + (size_t)(n_ * NH + h_) * (HD * HD) + (16 * w + fr) * HD + 8 * fq; \
        _Pragma("unroll") for (int k2 = 0; k2 < 4; ++k2) psb[k2] = *(const bf16x8*)(Sp_ + 32 * k2); } while (0)
    H3_PREFETCH(bx);
    const bool hfix = (G & 15) == 0;
    float l0 = P.lb_logits[(bx & 15) * HD + d], l1 = P.lb_logits[HW + (bx & 15) * HD + d], nwv = P.hgrn_nw[16 * w + fr];
    size_t yoff = 0; bool have_y = false;
#define H3_FLUSH() do { _Pragma("unroll") for (int rep = 0; rep < 2; ++rep) { const int cidx = tid + 512 * rep; \
        *(u32x4*)((unsigned short*)P.YAB + yoff + (size_t)(cidx >> 4) * D + (cidx & 15) * 8) = *(const LAS u32x4*)(YST + (cidx >> 4) * 128 + (cidx & 15) * 8); } } while (0)
    for (int it = bx; it < NIT; it += G) {
        const int n = it >> 4, h = it & 15, t0 = n * CH;
        if (!hfix) { l0 = P.lb_logits[h * HD + d]; l1 = P.lb_logits[HW + h * HD + d]; }
        tile_st(FST, pf, tid); tile_st(QST, pq, tid); vt_st(VT, pv, tid);
        bf16x8 sb[4];
#pragma unroll
        for (int k2 = 0; k2 < 4; ++k2) sb[k2] = psb[k2];
        __syncthreads();
        const float oml = 1.f - __builtin_amdgcn_rcpf(1.f + __expf(l1 - l0));
        float kk[16], pc[16], qq[16], run = 1.f;
#pragma unroll
        for (int u = 0; u < 16; ++u) { const float xv = (float)FST[(16 * i + u) * 128 + d]; qq[u] = (float)QST[(16 * i + u) * 128 + d];
            const float k = oml * __builtin_amdgcn_rcpf(1.f + __expf(xv)); run *= (1.f - k); kk[u] = k; pc[u] = run; }
        tot[i * 128 + d] = run;
        for (int z = tid; z < 64 * 72 / 8; z += 512) ((LAS u32x4*)Pm)[z] = (u32x4){0u, 0u, 0u, 0u};
        if (tid < 64) red[tid] = 0.f;
        __syncthreads();
        tile_st(GST, pg, tid);
        {
            float tt[4];
#pragma unroll
            for (int j = 0; j < 4; ++j) tt[j] = tot[j * 128 + d];
            float er = 1.f;
#pragma unroll
            for (int j = 0; j < 4; ++j) if (j < i) er *= tt[j];
            float erho[4];
#pragma unroll
            for (int ip = 0; ip < 4; ++ip) { float rho = 1.f;
#pragma unroll
                for (int j = 0; j < 4; ++j) if (j >= i && j < ip) rho *= tt[j];
                erho[ip] = rho; }
            float kd[16];
#pragma unroll
            for (int u = 0; u < 16; ++u) { const int t = 16 * i + u;
                const float q2 = qq[u] * pc[u]; kd[u] = kk[u] * __builtin_amdgcn_rcpf(pc[u]);
                Q2[t * QS + d] = bf1(q2);
                Q1[t * QS + d] = bf1(q2 * er); }
#pragma unroll
            for (int ip = 0; ip < 4; ++ip) {
                if (ip >= i) {
                    const int rb = 8 * ip * (ip + 1) + 16 * i;
#pragma unroll
                    for (int u = 0; u < 16; ++u) KH[(rb + u) * QS + d] = bf1(kd[u] * erho[ip]);
                }
            }
        }
        if (have_y) H3_FLUSH();
        { const int nit = it + G; H3_PREFETCH(nit < NIT ? nit : it); }
        __syncthreads();
        for (int idx = w; idx < 10; idx += 8) {
            const int i2 = idx >= 6 ? 3 : (idx >= 3 ? 2 : (idx >= 1 ? 1 : 0)), j2 = idx - (i2 * (i2 + 1)) / 2;
            f32x4 sc = (f32x4){0.f, 0.f, 0.f, 0.f};
#pragma unroll
            for (int k2 = 0; k2 < 4; ++k2) {
                const bf16x8 a = *(const LAS bf16x8*)(Q2 + (16 * i2 + fr) * QS + 32 * k2 + 8 * fq);
                const bf16x8 b = *(const LAS bf16x8*)(KH + (8 * i2 * (i2 + 1) + 16 * j2 + fr) * QS + 32 * k2 + 8 * fq);
                sc = __builtin_amdgcn_mfma_f32_16x16x32_bf16(a, b, sc, 0, 0, 0);
            }
#pragma unroll
            for (int jj = 0; jj < 4; ++jj) { const int tl = 4 * fq + jj; const float v = (i2 == j2 && fr > tl) ? 0.f : sc[jj];
                Pm[(16 * i2 + tl) * 72 + 16 * j2 + fr] = bf1(v); }
        }
        __syncthreads();
        f32x4 o[4];
#pragma unroll
        for (int m = 0; m < 4; ++m) o[m] = (f32x4){0.f, 0.f, 0.f, 0.f};
#pragma unroll
        for (int k2 = 0; k2 < 4; ++k2)
#pragma unroll
            for (int m = 0; m < 4; ++m) { const bf16x8 a = *(const LAS bf16x8*)(Q1 + (16 * m + fr) * QS + 32 * k2 + 8 * fq);
                o[m] = __builtin_amdgcn_mfma_f32_16x16x32_bf16(a, sb[k2], o[m], 0, 0, 0); }
#pragma unroll
        for (int k2 = 0; k2 < 2; ++k2) { const bf16x8 b = *(const LAS bf16x8*)(VT + vt_idx(16 * w + fr, 32 * k2 + 8 * fq));
#pragma unroll
            for (int m = 0; m < 4; ++m) { if (k2 == 1 && m < 2) continue;
                const bf16x8 a = *(const LAS bf16x8*)(Pm + (16 * m + fr) * 72 + 32 * k2 + 8 * fq);
                o[m] = __builtin_amdgcn_mfma_f32_16x16x32_bf16(a, b, o[m], 0, 0, 0); } }
#pragma unroll
        for (int m = 0; m < 4; ++m)
#pragma unroll
            for (int jj = 0; jj < 4; ++jj) { const float sq = row16_sum(o[m][jj] * o[m][jj]);
                if (fr == 0) __builtin_amdgcn_ds_faddf(red + 16 * m + 4 * fq + jj, sq, 0, 0, false); }
        __syncthreads();
        const int e = 16 * w + fr;
#pragma unroll
        for (int m = 0; m < 4; ++m)
#pragma unroll
            for (int jj = 0; jj < 4; ++jj) { const int t = 16 * m + 4 * fq + jj; const float ss = red[t];
                const float rs = rsqrtf(ss * (1.f / HD) + EPS);
                const float gv = (float)GST[t * 128 + e];
                const float yv = o[m][jj] * rs * nwv * gv * sigmoidf_(gv);
#if GEMM_BF16
                YST[t * 128 + e] = bf1(yv);
#else
                YST[t * 128 + e] = __builtin_bit_cast(unsigned short, (h16)yv);
#endif
            }
        yoff = (size_t)t0 * D + h * HD; have_y = true;
    }
    __syncthreads();
    if (have_y) H3_FLUSH();
#undef H3_FLUSH
#undef H3_PREFETCH
}

__device__ __forceinline__ void final_phase(const Ptrs& P, int G, int tid) {
    const int lane = tid & 63, wave = tid >> 6;
    f32x4 fw[8][2];
#pragma unroll
    for (int j = 0; j < 8; ++j) { fw[j][0] = *(const f32x4*)(P.final_nw + 8 * (lane + 64 * j)); fw[j][1] = *(const f32x4*)(P.final_nw + 8 * (lane + 64 * j) + 4); }
    for (int row = blockIdx.x * 8 + wave; row < T; row += G * 8) {
        const float rs = rsqrtf(P.ssq[row] * (1.f / D) + EPS);
        const h16x8* hp = (const h16x8*)(P.U + (size_t)row * D) + lane;
        h16x8 hv[8];
#pragma unroll
        for (int j = 0; j < 8; ++j) hv[j] = hp[64 * j];
        f32x4* o = (f32x4*)(P.out + (size_t)row * D) + 2 * lane;
#pragma unroll
        for (int j = 0; j < 8; ++j) {
            f32x4 a0, a1;
#pragma unroll
            for (int q = 0; q < 4; ++q) { a0[q] = (float)hv[j][q] * rs * fw[j][0][q]; a1[q] = (float)hv[j][4 + q] * rs * fw[j][1][q]; }
            o[128 * j] = a0; o[128 * j + 1] = a1; }
    }
}

__device__ __forceinline__ unsigned long long ldptr(LAS const unsigned long long* pt, int k) {
    const unsigned long long v = pt[k]; const unsigned lo = __builtin_amdgcn_readfirstlane((unsigned)v), hi = __builtin_amdgcn_readfirstlane((unsigned)(v >> 32));
    return ((unsigned long long)hi << 32) | lo;
}
#define GAS __attribute__((address_space(1)))
#define GP(T, v) ((T*)(GAS T*)(v))
__device__ __forceinline__ Ptrs mkptrs(LAS const unsigned long long* pt) {
    Ptrs P;
    P.x = GP(const float, ldptr(pt, 0)); P.norm_w = GP(const float, ldptr(pt, 1)); P.w_in = GP(const float, ldptr(pt, 2)); P.lb_logits = GP(const float, ldptr(pt, 3)); P.hgrn_nw = GP(const float, ldptr(pt, 4));
    P.conv_w = GP(const float, ldptr(pt, 5)); P.w_a = GP(const float, ldptr(pt, 6)); P.w_b = GP(const float, ldptr(pt, 7)); P.gate_bias = GP(const float, ldptr(pt, 8)); P.w_out = GP(const float, ldptr(pt, 9));
    P.final_nw = GP(const float, ldptr(pt, 10)); P.out = GP(float, ldptr(pt, 11));
    const unsigned long long ws = ldptr(pt, 12);
    P.ssq = GP(float, ws + WS_SSQ); P.Dn = GP(float, ws + WS_DN);
    P.W1T = GP(h16, ws + WS_W1T); P.WABT = GP(h16, ws + WS_WABT); P.WOT = GP(h16, ws + WS_WOT); P.U = GP(h16, ws + WS_U);
    P.PA = GP(h16, ws + WS_PA); P.PG = GP(h16, ws + WS_PG); P.PP = GP(h16, ws + WS_PP); P.PGG = GP(h16, ws + WS_PGG);
    P.YAB = GP(h16, ws + WS_YAB); P.L = GP(h16, ws + WS_L); P.S = GP(unsigned short, ws + WS_S); P.MG = GP(h16, ws + WS_MG); P.U8 = GP(unsigned char, ws + WS_U8); P.W8T = GP(unsigned char, ws + WS_W8T); P.cnt = GP(unsigned, ws + WS_CNT);
    return P;
}


#define XB_TMO      128
#define XB_XCNT(j)  (256  + 64 * (j))
#define XB_XSUB(j)  (1280 + 64 * (j))
#define XB_XGEN(j)  (2304 + 64 * (j))
#define XB_TOP      3328
#define XB_TOPGEN   3392
#define XCD_BAR_WORDS 3456
#define XB_SPIN_CAP (1u << 22)
__device__ __forceinline__ unsigned xb_ld(unsigned* p)              { return __hip_atomic_load(p, __ATOMIC_RELAXED, __HIP_MEMORY_SCOPE_AGENT); }
__device__ __forceinline__ unsigned xb_add(unsigned* p, unsigned v) { return __hip_atomic_fetch_add(p, v, __ATOMIC_RELAXED, __HIP_MEMORY_SCOPE_AGENT); }
__device__ __forceinline__ unsigned xb_xcc_id() { return (unsigned)__builtin_amdgcn_s_getreg((3 << 11) | 20) & 0xFu; }
#define XB_SPIN(cond, bar) do { unsigned _sp = 0; while (cond) { __builtin_amdgcn_s_sleep(1); \
    if ((++_sp & 255u) == 0u) { if (xb_ld(&(bar)[XB_TMO])) break; if (_sp > XB_SPIN_CAP) { atomicAdd(&(bar)[XB_TMO], 1u); break; } } } } while (0)
__device__ __forceinline__ void xcd_barrier_complete(unsigned* bar, unsigned x, unsigned& nloc, unsigned& nx) {
    const unsigned G = gridDim.x;
    unsigned sum, cnt, mine, sp = 0u;
    for (;;) {
        sum = 0u; cnt = 0u; mine = 0u;
#pragma unroll
        for (unsigned j = 0; j < 16; ++j) { const unsigned c = xb_ld(&bar[XB_XCNT(j)]); sum += c; cnt += (c > 0u) ? 1u : 0u; mine = (j == x) ? c : mine; }
        if (sum == G) break;
        __builtin_amdgcn_s_sleep(1);
        if ((++sp & 255u) == 0u) { if (xb_ld(&bar[XB_TMO])) break; if (sp > XB_SPIN_CAP) { atomicAdd(&bar[XB_TMO], 1u); break; } }
    }
    nloc = mine > 0u ? mine : 1u; nx = cnt > 0u ? cnt : 1u;
}
__device__ __forceinline__ void xcd_barrier(unsigned* bar, volatile LAS unsigned* st, bool is_t0) {
    asm volatile("s_waitcnt vmcnt(0)" ::: "memory");
    __syncthreads();
    if (is_t0) {
        __builtin_amdgcn_s_waitcnt(0);
        const unsigned x = xb_xcc_id();
        unsigned nloc = st[0], nx = st[1];
        if (nloc == 0u) { xcd_barrier_complete(bar, x, nloc, nx); st[0] = nloc; st[1] = nx; }
        const unsigned old = xb_add(&bar[XB_XSUB(x)], 1u);
        const unsigned gen = old / nloc;
        if (old + 1u == (gen + 1u) * nloc) {
            __builtin_amdgcn_fence(__ATOMIC_RELEASE, "agent");
            asm volatile("s_waitcnt vmcnt(0)" ::: "memory");
            const unsigned og = xb_add(&bar[XB_TOP], 1u);
            const unsigned tg = og / nx;
            if (og + 1u == (tg + 1u) * nx) xb_add(&bar[XB_TOPGEN], 1u);
            else XB_SPIN(xb_ld(&bar[XB_TOPGEN]) == tg, bar);
            __builtin_amdgcn_fence(__ATOMIC_ACQUIRE, "agent");
            xb_add(&bar[XB_XGEN(x)], 1u);
            asm volatile("s_waitcnt vmcnt(0)" ::: "memory");
        } else {
            XB_SPIN(xb_ld(&bar[XB_XGEN(x)]) == gen, bar);
            __builtin_amdgcn_fence(__ATOMIC_ACQUIRE, "agent");
            asm volatile("s_waitcnt vmcnt(0)" ::: "memory");
        }
    }
    __syncthreads();
}

struct Args { const float* in[11]; float* out; unsigned char* ws; int ph_lo, ph_hi; };
constexpr int NPH = 8;

template <int COOP>
__global__ void __launch_bounds__(512, 2) mega(Args a) {
    extern __shared__ __attribute__((aligned(16))) unsigned char lds_raw[];
    LAS unsigned char* lds = (LAS unsigned char*)lds_raw;
    const int G = gridDim.x, bx = blockIdx.x, wave0 = __builtin_amdgcn_readfirstlane((int)threadIdx.x >> 6);
    const int vcu = (G % 8 == 0) ? (bx % 8) * (G / 8) + bx / 8 : bx;
    LAS unsigned long long* ptab = (LAS unsigned long long*)(lds + LDS_CTL);
    { const int t0_ = fresh_tid(); if (t0_ < 13) ptab[t0_] = (t0_ < 11) ? (unsigned long long)a.in[t0_] : (t0_ == 11 ? (unsigned long long)a.out : (unsigned long long)a.ws); }
    volatile LAS unsigned* xst = (volatile LAS unsigned*)(lds + LDS_CTL + 128);
    unsigned* xbar = nullptr;
    if constexpr (COOP) {
        xbar = GP(unsigned, (unsigned long long)a.ws + WS_BAR);
        if (lane_id_fresh() == 0 && wave0 == 0) { xst[0] = 0u; xst[1] = 0u; (void)xb_add(&xbar[XB_XCNT(xb_xcc_id())], 1u); }
    }
    __syncthreads();
    const int lo = a.ph_lo, hi = a.ph_hi;
#define IN(k) (((PHMASK >> (k)) & 1) && (COOP || (lo <= (k) && (k) < hi)))
#ifndef CG_SEAM
#define CG_SEAM 0
#endif
#define SEAM(k) do { if constexpr (COOP) { if (IN(k) && IN((k) + 1)) { if ((k) == CG_SEAM) cg::this_grid().sync(); else xcd_barrier(xbar, xst, lane_id_fresh() == 0 && wave0 == 0); } } } while (0)

    if (IN(0)) REP(0) { const Ptrs P = mkptrs(ptab); p0_prologue(P, lds, vcu, G, fresh_tid()); }
    SEAM(0);
    if (IN(1)) REP(1) { const Ptrs P = mkptrs(ptab);
#ifndef NO_G1A
        { pg8::Gemm g{P.U, P.W1T, T, 16384, D, D}; pg8::StaticOrder S; S.init(T, 16384, G, bx);
          pg8::EpiG1 E{P.PA, P.PP, P.PGG};
          pg8::gemm_phase<pg8::EpiG1, pg8::StaticOrder, false>(lds, g, S, E, fresh_tid()); }
#endif
#ifndef NO_G1B
        { pg8::Gemm g{P.U8, P.W8T, T, 8192, D / 2, D / 2}; pg8::StaticOrder S; S.init(T, 8192, G, bx);
          pg8::EpiGate E{P.PG, P.gate_bias};
          pg8::gemm_phase<pg8::EpiGate, pg8::StaticOrder, true>(lds, g, S, E, fresh_tid()); }
#endif
    }
    SEAM(1);
    if (IN(2)) REP(2) { const Ptrs P = mkptrs(ptab);
        h1_phase(P, lds, bx, G, fresh_tid());
        __syncthreads();
        yb_phase(P, G, fresh_tid());
    }
    SEAM(2);
    if (IN(3)) REP(3) { const Ptrs P = mkptrs(ptab); h2_phase(P, G, fresh_tid()); }
    SEAM(3);
    if (IN(4)) REP(4) { const Ptrs P = mkptrs(ptab);
        h3_phase(P, lds, bx, G, fresh_tid());
        __syncthreads();
    }
    SEAM(4);
    if (IN(5)) REP(5) { const Ptrs P = mkptrs(ptab);
        pg8::Gemm g{P.YAB, P.WABT, T, D, 4096, HW}; pg8::StaticOrder S; S.init(T, D, G, bx, 2, 4);
        pg8::EpiG2 E{P.PG, P.MG};
        pg8::gemm_phase(lds, g, S, E, fresh_tid());
    }
    SEAM(5);
    if (IN(6)) { const Ptrs P = mkptrs(ptab);
        pg8::Gemm g{P.MG, P.WOT, T, D, D, D}; pg8::StaticOrder S; S.init(T, D, G, bx, 1, 4);
        pg8::EpiG3 E{P.x, P.U, P.ssq, P.cnt};
        pg8::gemm_phase(lds, g, S, E, fresh_tid());
        if constexpr (COOP) {
            const int tid = fresh_tid(); pg8::Unit u;
            for (int ui = 0; S.next(ui, u); ++ui) pg8::final_tile(u, P.U, P.ssq, P.cnt, P.final_nw, P.out, tid);
        }
    }
    if constexpr (!COOP) { if (IN(7)) { const Ptrs P = mkptrs(ptab); final_phase(P, G, fresh_tid()); } }
#undef IN
#undef SEAM
}

extern "C" void kernel_launch(void* const* d_in, const int* in_sizes, int n_in, void* d_out, int out_size, void* d_ws, size_t ws_size, hipStream_t stream) {
    static int grid = 0;
    if (grid == 0) {
        if (n_in != 11 || in_sizes[0] != T * D || out_size != T * D || ws_size < WS_END) { fprintf(stderr, "kernel_launch: unexpected shapes / workspace (n_in %d, ws %zu, need %zu)\n", n_in, ws_size, (size_t)WS_END); grid = -1; return; }
        int dev = 0, cus = 0, per_cu = 0;
        (void)hipGetDevice(&dev); (void)hipDeviceGetAttribute(&cus, hipDeviceAttributeMultiprocessorCount, dev);
        constexpr int KCOOP = (N_LAUNCHES == 1) ? 1 : 0;
        (void)hipFuncSetAttribute((const void*)mega<KCOOP>, hipFuncAttributeMaxDynamicSharedMemorySize, LDS_BYTES);
        if (hipOccupancyMaxActiveBlocksPerMultiprocessor(&per_cu, (const void*)mega<KCOOP>, 512, LDS_BYTES) != hipSuccess || per_cu < 1) { fprintf(stderr, "kernel_launch: occupancy query failed (%d)\n", per_cu); (void)hipGetLastError(); grid = -1; return; }
        grid = cus * 1;
        if (grid <= 0) grid = 256;
    }
    if (grid < 0) return;
    Args a{};
    for (int i = 0; i < 11; ++i) a.in[i] = (const float*)d_in[i];
    a.out = (float*)d_out; a.ws = (unsigned char*)d_ws;
#if N_LAUNCHES == 1
    (void)hipMemsetAsync((char*)d_ws + WS_BAR, 0, 16384 + 32 * 256, stream);
    a.ph_lo = 0; a.ph_hi = NPH;
    void* args[] = {&a};
    hipError_t e = hipLaunchCooperativeKernel((const void*)mega<1>, dim3(grid), dim3(512), args, LDS_BYTES, stream);
    if (e != hipSuccess) fprintf(stderr, "cooperative launch failed: %s (grid %d)\n", hipGetErrorString(e), grid);
#else
    for (int p = 0; p < NPH; ++p) { a.ph_lo = p; a.ph_hi = p + 1; hipLaunchKernelGGL(mega<0>, dim3(grid), dim3(512), LDS_BYTES, stream, a); }
#endif
}
```

```cpp
#include <hip/hip_runtime.h>
#include <hip/hip_cooperative_groups.h>
#include <cstdio>
#include <cstdint>
namespace cg = cooperative_groups;

#ifndef N_LAUNCHES
#define N_LAUNCHES 1
#endif

#ifndef PHMASK
#define PHMASK 255
#endif
#ifndef ORDER_SHARED_B
#define ORDER_SHARED_B 0
#endif
#ifndef REPMASK
#define REPMASK 0
#endif
#define REP(k) for (int rep_ = 0; rep_ < (((REPMASK >> (k)) & 1) ? 2 : 1); ++rep_)
#define LAS __attribute__((address_space(3)))
typedef _Float16 h16;
typedef _Float16 h16x8 __attribute__((ext_vector_type(8)));
typedef _Float16 h16x4 __attribute__((ext_vector_type(4)));
typedef _Float16 h16x2 __attribute__((ext_vector_type(2)));
typedef short bf16x8 __attribute__((ext_vector_type(8)));
typedef float f32x4 __attribute__((ext_vector_type(4)));
typedef float f32x2 __attribute__((ext_vector_type(2)));
typedef unsigned u32x4 __attribute__((ext_vector_type(4)));
typedef unsigned u32x2 __attribute__((ext_vector_type(2)));
typedef int i32x8 __attribute__((ext_vector_type(8)));
typedef int i32x4 __attribute__((ext_vector_type(4)));

constexpr int T = 8192, D = 4096, NIN = 24576, HW = 2048, NH = 16, HD = 128, CH = 64, NCH = T / CH;
constexpr float EPS = 1e-6f;

constexpr size_t MiB = 1u << 20;
constexpr size_t WS_SSQ = 0;
constexpr size_t WS_BAR = 65536;
constexpr size_t WS_CNT = WS_BAR + 16384;
constexpr size_t WS_DN = 1 * MiB;
constexpr size_t WS_W1T = 2 * MiB;
constexpr size_t WS_WABT = WS_W1T + 192 * MiB;
constexpr size_t WS_WOT = WS_WABT + 32 * MiB;
constexpr size_t WS_U = WS_WOT + 32 * MiB;
constexpr size_t WS_PA = WS_U + 64 * MiB;
constexpr size_t WS_PG = WS_PA + 128 * MiB;
constexpr size_t WS_PP = WS_PG + 128 * MiB;
constexpr size_t WS_PGG = WS_PP + 32 * MiB;
constexpr size_t WS_YAB = WS_PGG + 32 * MiB;
constexpr size_t WS_L = WS_YAB + 64 * MiB;
constexpr size_t WS_S = WS_L + 64 * MiB;
constexpr size_t WS_MG = WS_S + 64 * MiB;
constexpr size_t WS_U8 = WS_MG + 64 * MiB;
constexpr size_t WS_W8T = WS_U8 + 32 * MiB;
constexpr size_t WS_END = WS_W8T + 32 * MiB;
constexpr float F8_SU = 8.f, F8_SW = 256.f;

constexpr int LDS_CTL = 147456;
constexpr int LDS_BYTES = LDS_CTL + 256;

__device__ __forceinline__ unsigned f2bf(float f) { unsigned u = __builtin_bit_cast(unsigned, f); return (u + 0x7fffu + ((u >> 16) & 1u)) >> 16; }
__device__ __forceinline__ unsigned pkh(float lo, float hi) { h16x2 v; v.x = (h16)lo; v.y = (h16)hi; return __builtin_bit_cast(unsigned, v); }
#ifndef GEMM_BF16
#define GEMM_BF16 1
#endif
__device__ __forceinline__ unsigned pkg(float lo, float hi) {
#if GEMM_BF16
    unsigned r; asm("v_cvt_pk_bf16_f32 %0, %1, %2" : "=v"(r) : "v"(lo), "v"(hi)); return r;
#else
    return pkh(lo, hi);
#endif
}
__device__ __forceinline__ float wave_sum(float v) {
#pragma unroll
    for (int o = 1; o < 64; o <<= 1) v += __shfl_xor(v, o);
    return v;
}
__device__ __forceinline__ int lane_id_fresh() { int t; asm volatile("v_mbcnt_lo_u32_b32 %0, -1, 0\n\tv_mbcnt_hi_u32_b32 %0, -1, %0" : "=v"(t)); return t; }
#define fresh_tid() ((wave0 << 6) | lane_id_fresh())
__device__ __forceinline__ float sigmoidf_(float x) { return __builtin_amdgcn_rcpf(1.f + __expf(-x)); }

namespace pg8 {
constexpr int BM = 256, BK = 64, HALF = 128, HTB = HALF * BK * 2, STAGE_BYTES = 8 * HTB, NXCD = 8, WGM = 8;
__host__ __device__ __forceinline__ int lds_byte(int r, int c) { const int st = (r >> 4) * 2 + (c >> 5), rr = r & 15, cc = c & 31, ob = rr * 64 + cc * 2; return st * 1024 + (ob ^ (((ob >> 9) & 1) << 5)); }
__host__ __device__ __forceinline__ void stage_rc(int b, int& R, int& C) { const int st = b / 1024, sb = b % 1024, swz = sb ^ (((sb >> 9) & 1) << 5); R = (st >> 1) * 16 + swz / 64; C = (st & 1) * 32 + (swz % 64) / 2; }
__host__ __device__ __forceinline__ int perm32(int rho) { const int n = rho >> 4, i = rho & 15; return 8 * (i >> 2) + 4 * n + (i & 3); }

struct Unit { int pm, pn, half; };
struct Gemm { const void* A; const void* Bt; int M, N, K, Kloop; };
struct StaticOrder {
    int nM, nN, nwg, G, c, halves, wgm;
    __device__ void init(int M, int N, int G_, int c_, int halves_ = 1, int wgm_ = WGM) { nM = M / BM; nN = N / BM; nwg = nM * nN; G = G_; c = c_; halves = halves_; wgm = wgm_; }
    __device__ bool next(int i, Unit& u) const {
        const int ti = halves == 2 ? (i >> 1) : i; u.half = halves == 2 ? (i & 1) : 0;
#if ORDER_SHARED_B
        if (G == 256 && nM == 32 && (nN & 7) == 0) {
            if (ti >= (nN >> 3)) return false;
            const int x = c & 7, j = c >> 3; u.pm = 4 * x + (j & 3); u.pn = 8 * ti + (j >> 2); return true;
        }
#endif
        const long L = (long)ti * G + c; if (L >= nwg) return false;
        int wgid = (int)L; { const int q = nwg / NXCD, r = nwg % NXCD, xcd = wgid % NXCD, off = wgid / NXCD; wgid = (xcd < r ? xcd * (q + 1) : r * (q + 1) + (xcd - r) * q) + off; }
        const int nig = wgm * nN, gid = wgid / nig, fm = gid * wgm, gsz = (nM - fm) < wgm ? (nM - fm) : wgm;
        u.pm = fm + ((wgid % nig) % gsz); u.pn = (wgid % nig) / gsz; return true;
    }
};

template <class Epi, class Sched, bool FP8 = false>
__device__ __forceinline__ void gemm_phase(LAS unsigned char* lds, const Gemm g, const Sched& S, const Epi& E, const int tid) {
    const int wid = __builtin_amdgcn_readfirstlane(tid >> 6), lane = tid & 63, wr = wid >> 2, wc = wid & 3, fr = lane & 15, fq = lane >> 4;
    const int K = g.K, nt = g.Kloop / BK;
    const size_t halfb = (size_t)g.Kloop * 2;
    const int sc8 = 0x7f7f7f7f;
    unsigned voffA[2];
#pragma unroll
    for (int i = 0; i < 2; ++i) { int R, C; stage_rc(tid * 16 + i * 8192, R, C); voffA[i] = (unsigned)(R * K + C) * 2u; }
    const size_t kstep = (size_t)(BK * 2);
    const size_t hstep = (size_t)HALF * K * 2;
    const size_t tstep = 2 * hstep;
    const unsigned ldsw = (unsigned)wid * 1024u;
    const int aoff = lds_byte(wr * 64 + fr, fq * 8), boff = lds_byte(wc * 32 + fr, fq * 8);
#define PG8_SA(b, h) (((b) * 2 + (h)) * HTB)
#define PG8_SB(b, h) ((4 + (b) * 2 + (h)) * HTB)
#define PG8_STAGE(bufoff, gbase) do { _Pragma("unroll") for (int _i = 0; _i < 2; ++_i) \
        __builtin_amdgcn_global_load_lds((const unsigned*)((const char*)(gbase) + voffA[_i]), (LAS unsigned*)(lds + (bufoff) + ldsw + _i * 8192), 16, 0, 0); } while (0)
#define PG8_LDA(dst, b, h) do { _Pragma("unroll") for (int m = 0; m < 4; ++m) _Pragma("unroll") for (int k = 0; k < 2; ++k) dst[m][k] = *(const LAS h16x8*)(lds + PG8_SA(b, h) + aoff + m * 2048 + k * 1024); } while (0)
#define PG8_LDB(dst, b, h) do { _Pragma("unroll") for (int n = 0; n < 2; ++n) _Pragma("unroll") for (int k = 0; k < 2; ++k) dst[n][k] = *(const LAS h16x8*)(lds + PG8_SB(b, h) + boff + n * 2048 + k * 1024); } while (0)
#define PG8_MMA(ai, bj, At, Bt) do { __builtin_amdgcn_s_setprio(1); _Pragma("unroll") for (int m = 0; m < 4; ++m) _Pragma("unroll") for (int n = 0; n < 2; ++n) { \
        if constexpr (FP8) { const i32x8 b8_ = __builtin_shufflevector(__builtin_bit_cast(i32x4, Bt[n][0]), __builtin_bit_cast(i32x4, Bt[n][1]), 0, 1, 2, 3, 4, 5, 6, 7); \
            const i32x8 a8_ = __builtin_shufflevector(__builtin_bit_cast(i32x4, At[m][0]), __builtin_bit_cast(i32x4, At[m][1]), 0, 1, 2, 3, 4, 5, 6, 7); \
            asm volatile("v_mfma_scale_f32_16x16x128_f8f6f4 %0, %1, %2, %0, %3, %3 op_sel_hi:[0,0,0]" : "+v"(acc[ai][bj][m][n]) : "v"(b8_), "v"(a8_), "v"(sc8)); } \
        else { _Pragma("unroll") for (int k = 0; k < 2; ++k) acc[ai][bj][m][n] = PG8_MFMA(Bt[n][k], At[m][k], acc[ai][bj][m][n]); } } \
        __builtin_amdgcn_s_setprio(0); } while (0)
#if GEMM_BF16
#define PG8_MFMA(a, b, c) __builtin_amdgcn_mfma_f32_16x16x32_bf16(__builtin_bit_cast(bf16x8, a), __builtin_bit_cast(bf16x8, b), c, 0, 0, 0)
#else
#define PG8_MFMA(a, b, c) __builtin_amdgcn_mfma_f32_16x16x32_f16(a, b, c, 0, 0, 0)
#endif
#define PG8_WAIT_V(n) asm volatile("s_waitcnt vmcnt(" #n ")" ::: "memory")
#define PG8_WAIT_L(n) asm volatile("s_waitcnt lgkmcnt(" #n ")" ::: "memory")
#define PG8_BAR __builtin_amdgcn_s_barrier()
#define PG8_SCHED __builtin_amdgcn_sched_barrier(0)
    Unit cur, nxt; int ui = 0;
    if (!S.next(0, cur)) return;
    f32x4 acc[2][2][4][2];
#pragma unroll
    for (int a = 0; a < 2; ++a)
#pragma unroll
        for (int b = 0; b < 2; ++b)
#pragma unroll
            for (int m = 0; m < 4; ++m)
#pragma unroll
                for (int n = 0; n < 2; ++n) acc[a][b][m][n] = (f32x4){0.f, 0.f, 0.f, 0.f};
    h16x8 At[4][2], B0[2][2], B1[2][2];
    const char* cA = (const char*)g.A + (size_t)cur.pm * tstep + cur.half * halfb; const char* cB = (const char*)g.Bt + (size_t)cur.pn * tstep + cur.half * halfb;
    PG8_STAGE(PG8_SB(0, 0), cB); PG8_STAGE(PG8_SB(0, 1), cB + hstep); PG8_STAGE(PG8_SA(0, 0), cA); PG8_STAGE(PG8_SA(0, 1), cA + hstep);
    if (wr == 1) PG8_BAR;
    PG8_WAIT_V(2); PG8_BAR;
    PG8_STAGE(PG8_SB(1, 0), cB + kstep); PG8_STAGE(PG8_SA(1, 0), cA + kstep); PG8_STAGE(PG8_SB(1, 1), cB + hstep + kstep);
    PG8_WAIT_V(6); PG8_BAR;
    for (;;) {
        const bool has_next = S.next(ui + 1, nxt);
        const char* nA = has_next ? (const char*)g.A + (size_t)nxt.pm * tstep + nxt.half * halfb : cA; const char* nB = has_next ? (const char*)g.Bt + (size_t)nxt.pn * tstep + nxt.half * halfb : cB;
#define PG8_KBODY(t) do { \
            const bool last = (t == nt - 2); \
            const char* a1 = cA + (size_t)(t + 1) * kstep; \
            const char* a2 = last ? nA : cA + (size_t)(t + 2) * kstep; const char* b2 = last ? nB : cB + (size_t)(t + 2) * kstep; \
            const char* a3 = a2 + kstep; const char* b3 = b2 + kstep; \
            PG8_LDB(B0, 0, 0); PG8_LDB(B1, 0, 1); PG8_SCHED; PG8_LDA(At, 0, 0); PG8_STAGE(PG8_SA(1, 1), a1 + hstep); \
            PG8_WAIT_V(8); PG8_WAIT_L(0); PG8_BAR; PG8_MMA(0, 0, At, B0); PG8_MMA(0, 1, At, B1); PG8_BAR; PG8_SCHED; \
            PG8_LDA(At, 0, 1); PG8_STAGE(PG8_SB(0, 0), b2); PG8_STAGE(PG8_SB(0, 1), b2 + hstep); PG8_STAGE(PG8_SA(0, 0), a2); \
            PG8_WAIT_V(8); PG8_WAIT_L(0); PG8_BAR; PG8_MMA(1, 0, At, B0); PG8_MMA(1, 1, At, B1); PG8_BAR; PG8_SCHED; \
            PG8_LDB(B0, 1, 0); PG8_LDB(B1, 1, 1); PG8_SCHED; PG8_LDA(At, 1, 0); PG8_STAGE(PG8_SA(0, 1), a2 + hstep); \
            PG8_WAIT_V(8); PG8_WAIT_L(0); PG8_BAR; PG8_MMA(0, 0, At, B0); PG8_MMA(0, 1, At, B1); PG8_BAR; PG8_SCHED; \
            PG8_LDA(At, 1, 1); PG8_STAGE(PG8_SB(1, 0), b3); PG8_STAGE(PG8_SB(1, 1), b3 + hstep); PG8_STAGE(PG8_SA(1, 0), a3); \
            PG8_WAIT_V(8); PG8_WAIT_L(0); PG8_BAR; PG8_MMA(1, 0, At, B0); PG8_MMA(1, 1, At, B1); PG8_BAR; PG8_SCHED; \
        } while (0)
        for (int t = 0; t < nt; t += 2) PG8_KBODY(t);
#undef PG8_KBODY
        if (wr == 0) PG8_BAR;
        if constexpr (FP8) asm volatile("s_nop 15\n\ts_nop 15" ::: "memory");
        E(acc, cur, wr, wc, fr, fq);
        if (!has_next) break;
        if (!Epi::MID || cur.half == 1)
#pragma unroll
        for (int a = 0; a < 2; ++a)
#pragma unroll
            for (int b = 0; b < 2; ++b)
#pragma unroll
                for (int m = 0; m < 4; ++m)
#pragma unroll
                    for (int n = 0; n < 2; ++n) acc[a][b][m][n] = (f32x4){0.f, 0.f, 0.f, 0.f};
        cur = nxt; cA = nA; cB = nB; ++ui;
        if (wr == 1) PG8_BAR;
    }
    PG8_WAIT_V(0);
    PG8_BAR;
#undef PG8_SA
#undef PG8_SB
#undef PG8_STAGE
#undef PG8_LDA
#undef PG8_LDB
#undef PG8_MMA
#undef PG8_MFMA
#undef PG8_WAIT_V
#undef PG8_WAIT_L
#undef PG8_BAR
#undef PG8_SCHED
}

struct EpiG1 {
    static constexpr bool MID = false;
    h16* PA; h16* PP; h16* PGG;
    __device__ __forceinline__ void operator()(const f32x4 (&acc)[2][2][4][2], const Unit& u, int wr, int wc, int fr, int fq) const {
        const int row0 = u.pm * BM + wr * 64 + fr;
        if ((u.pn & 1) == 0) {
            h16* base = PA + 256 * (u.pn >> 1) + wc * 32 + 8 * fq;
#pragma unroll
            for (int ai = 0; ai < 2; ++ai)
#pragma unroll
                for (int m = 0; m < 4; ++m) { h16* rowp = base + (size_t)(row0 + ai * HALF + m * 16) * 8192;
#pragma unroll
                    for (int bj = 0; bj < 2; ++bj) { const f32x4 v0 = acc[ai][bj][m][0], v1 = acc[ai][bj][m][1];
                        u32x4 w; w.x = pkh(v0[0], v0[1]); w.y = pkh(v0[2], v0[3]); w.z = pkh(v1[0], v1[1]); w.w = pkh(v1[2], v1[3]);
                        *(u32x4*)(rowp + bj * HALF) = w; } }
        } else {
            const int ti = u.pn >> 1, c0 = 128 * (ti >> 1) + 32 * wc + 8 * fq;
            h16* dst = (ti & 1) ? PGG : PP;
#pragma unroll
            for (int ai = 0; ai < 2; ++ai)
#pragma unroll
                for (int m = 0; m < 4; ++m) { const size_t off = (size_t)(row0 + ai * HALF + m * 16) * HW + c0;
                    float o[8];
                    if (ti & 1) {
#pragma unroll
                        for (int n = 0; n < 2; ++n)
#pragma unroll
                            for (int j = 0; j < 4; ++j) { const float g = acc[ai][1][m][n][j]; o[4 * n + j] = acc[ai][0][m][n][j] * g * sigmoidf_(g); }
                    } else {
#pragma unroll
                        for (int n = 0; n < 2; ++n)
#pragma unroll
                            for (int j = 0; j < 4; ++j) o[4 * n + j] = acc[ai][0][m][n][j] * acc[ai][1][m][n][j];
                    }
                    u32x4 w; w.x = pkh(o[0], o[1]); w.y = pkh(o[2], o[3]); w.z = pkh(o[4], o[5]); w.w = pkh(o[6], o[7]);
                    *(u32x4*)(dst + off) = w; }
        }
    }
};
struct EpiGate {
    static constexpr bool MID = false;
    h16* PG; const float* gbias;
    __device__ __forceinline__ void operator()(const f32x4 (&acc)[2][2][4][2], const Unit& u, int wr, int wc, int fr, int fq) const {
        const int row0 = u.pm * BM + wr * 64 + fr;
        const int c0 = u.pn * 128 + 32 * wc + 8 * fq;
        constexpr float DS = 1.f / (F8_SU * F8_SW);
        f32x4 ba[2], bb[2];
#pragma unroll
        for (int n = 0; n < 2; ++n) { ba[n] = *(const f32x4*)(gbias + c0 + 4 * n); bb[n] = *(const f32x4*)(gbias + D + c0 + 4 * n); }
#pragma unroll
        for (int ai = 0; ai < 2; ++ai)
#pragma unroll
            for (int m = 0; m < 4; ++m) { h16* rowp = PG + (size_t)(row0 + ai * HALF + m * 16) * 8192 + c0;
                float r[8], sg[8];
#pragma unroll
                for (int n = 0; n < 2; ++n)
#pragma unroll
                    for (int j = 0; j < 4; ++j) { const float ea = __expf(-(acc[ai][0][m][n][j] * DS + ba[n][j])), eb = __expf(-(acc[ai][1][m][n][j] * DS + bb[n][j]));
                        const float pa = 1.f + ea, pb = 1.f + eb, rp = __builtin_amdgcn_rcpf(pa * pb);
                        sg[4 * n + j] = pa * rp; r[4 * n + j] = pb * pb * rp; }
                u32x4 w; w.x = pkh(r[0], r[1]); w.y = pkh(r[2], r[3]); w.z = pkh(r[4], r[5]); w.w = pkh(r[6], r[7]);
                *(u32x4*)rowp = w;
                w.x = pkh(sg[0], sg[1]); w.y = pkh(sg[2], sg[3]); w.z = pkh(sg[4], sg[5]); w.w = pkh(sg[6], sg[7]);
                *(u32x4*)(rowp + D) = w; }
    }
};
struct EpiG2 {
    static constexpr bool MID = true;
    const h16* PG; h16* MG;
    __device__ __forceinline__ void operator()(f32x4 (&acc)[2][2][4][2], const Unit& u, int wr, int wc, int fr, int fq) const {
        const int row0 = u.pm * BM + wr * 64 + fr, col0 = u.pn * BM + wc * 32 + 8 * fq;
        const h16* gbase = PG + (size_t)row0 * 8192 + col0 + (u.half == 0 ? 0 : D);
#pragma unroll
        for (int ai = 0; ai < 2; ++ai) {
            h16x8 gt[4][2];
#pragma unroll
            for (int m = 0; m < 4; ++m)
#pragma unroll
                for (int bj = 0; bj < 2; ++bj) gt[m][bj] = *(const h16x8*)(gbase + (size_t)(ai * HALF + m * 16) * 8192 + bj * HALF);
            if (u.half == 0) {
#pragma unroll
                for (int m = 0; m < 4; ++m)
#pragma unroll
                    for (int bj = 0; bj < 2; ++bj)
#pragma unroll
                        for (int j = 0; j < 4; ++j) { acc[ai][bj][m][0][j] *= (float)gt[m][bj][j]; acc[ai][bj][m][1][j] *= (float)gt[m][bj][4 + j]; }
            } else {
#pragma unroll
                for (int m = 0; m < 4; ++m) { const size_t row = (size_t)(row0 + ai * HALF + m * 16);
#pragma unroll
                    for (int bj = 0; bj < 2; ++bj) { const int col = col0 + bj * HALF;
                        float o[8];
#pragma unroll
                        for (int j = 0; j < 4; ++j) { o[j] = acc[ai][bj][m][0][j] * (float)gt[m][bj][j]; o[4 + j] = acc[ai][bj][m][1][j] * (float)gt[m][bj][4 + j]; }
                        u32x4 w; w.x = pkg(o[0], o[1]); w.y = pkg(o[2], o[3]); w.z = pkg(o[4], o[5]); w.w = pkg(o[6], o[7]);
                        *(u32x4*)(MG + row * D + col) = w; } }
            }
            __builtin_amdgcn_sched_barrier(0);
        }
    }
};
struct EpiG3 {
    static constexpr bool MID = false;
    const float* x; h16* HB; float* ssq; unsigned* cnt;
    __device__ __forceinline__ void operator()(const f32x4 (&acc)[2][2][4][2], const Unit& u, int wr, int wc, int fr, int fq) const {
        const int row0 = u.pm * BM + wr * 64 + fr, col0 = u.pn * BM + wc * 32 + 8 * fq;
#pragma unroll
        for (int ai = 0; ai < 2; ++ai) {
            f32x4 xv[4][2][2];
#pragma unroll
            for (int m = 0; m < 4; ++m)
#pragma unroll
                for (int bj = 0; bj < 2; ++bj) { const float* xp = x + (size_t)(row0 + ai * HALF + m * 16) * D + col0 + bj * HALF; xv[m][bj][0] = *(const f32x4*)xp; xv[m][bj][1] = *(const f32x4*)(xp + 4); }
#pragma unroll
            for (int m = 0; m < 4; ++m) { const size_t row = (size_t)(row0 + ai * HALF + m * 16); float s = 0.f;
#pragma unroll
                for (int bj = 0; bj < 2; ++bj) { const size_t o = row * D + col0 + bj * HALF;
                    const f32x4 h0 = xv[m][bj][0] + acc[ai][bj][m][0], h1 = xv[m][bj][1] + acc[ai][bj][m][1];
                    s += (h0[0] * h0[0] + h0[1] * h0[1]) + (h0[2] * h0[2] + h0[3] * h0[3]) + (h1[0] * h1[0] + h1[1] * h1[1]) + (h1[2] * h1[2] + h1[3] * h1[3]);
                    u32x4 w; w.x = pkh(h0[0], h0[1]); w.y = pkh(h0[2], h0[3]); w.z = pkh(h1[0], h1[1]); w.w = pkh(h1[2], h1[3]);
                    *(u32x4*)(HB + o) = w; }
                s += __shfl_xor(s, 16); s += __shfl_xor(s, 32);
                if (fq == 0) (void)__hip_atomic_fetch_add(ssq + row, s, __ATOMIC_RELAXED, __HIP_MEMORY_SCOPE_AGENT); }
        }
        asm volatile("s_waitcnt vmcnt(0)" ::: "memory");
        if (fr == 0 && fq == 0) (void)__hip_atomic_fetch_add(cnt + 64 * u.pm, 1u, __ATOMIC_RELAXED, __HIP_MEMORY_SCOPE_AGENT);
    }
};
__device__ __forceinline__ void final_tile(const Unit& u, const h16* HB, float* ssq, unsigned* cnt, const float* fnw, float* out, int tid) {
    const int lane = tid & 63, wave = tid >> 6;
    if (tid == 0) {
        unsigned sp = 0;
        while (__hip_atomic_load(cnt + 64 * u.pm, __ATOMIC_RELAXED, __HIP_MEMORY_SCOPE_AGENT) < 16u * 8u) { __builtin_amdgcn_s_sleep(1); if (++sp > (1u << 24)) break; }
        __builtin_amdgcn_fence(__ATOMIC_ACQUIRE, "agent");
        asm volatile("s_waitcnt vmcnt(0)" ::: "memory");
    }
    __syncthreads();
    const int c0 = u.pn * BM + 4 * lane;
    const f32x4 w4 = *(const f32x4*)(fnw + c0);
#pragma unroll 1
    for (int rb = wave; rb < BM; rb += 64) {
        h16x4 hv[8]; float sq[8];
#pragma unroll
        for (int q = 0; q < 8; ++q) { const size_t row = (size_t)u.pm * BM + rb + 8 * q; hv[q] = *(const h16x4*)(HB + row * D + c0); sq[q] = __hip_atomic_load(ssq + row, __ATOMIC_RELAXED, __HIP_MEMORY_SCOPE_AGENT); }
#pragma unroll
        for (int q = 0; q < 8; ++q) { const size_t row = (size_t)u.pm * BM + rb + 8 * q; const float rs = rsqrtf(sq[q] * (1.f / D) + EPS);
            f32x4 o; o[0] = (float)hv[q][0] * rs * w4[0]; o[1] = (float)hv[q][1] * rs * w4[1]; o[2] = (float)hv[q][2] * rs * w4[2]; o[3] = (float)hv[q][3] * rs * w4[3];
            *(f32x4*)(out + row * D + c0) = o; }
    }
}
}

__device__ __forceinline__ int w1_col_of(int vr) {
    const int tile = vr >> 8, v = vr & 255;
    if (tile < 64) {
        const int ti = tile >> 1;
        if ((tile & 1) == 0) return 256 * ti + (v & ~31) + pg8::perm32(v & 31);
        const int bj = v >> 7, vv = v & 127, ch = 128 * (ti >> 1) + (vv & ~31) + pg8::perm32(vv & 31);
        const int kind = (ti & 1) ? (bj ? 3 : 0) : (bj ? 2 : 1);
        return 8192 + kind * HW + ch;
    }
    { const int c = tile - 64, bj = v >> 7, vv = v & 127; return 16384 + bj * D + 128 * c + (vv & ~31) + pg8::perm32(vv & 31); }
}
struct TItem { const float* src; h16* dst; int N, ldk; int f8; };
struct Ptrs {
    const float *x, *norm_w, *w_in, *lb_logits, *hgrn_nw, *conv_w, *w_a, *w_b, *gate_bias, *w_out, *final_nw;
    float* out; float* ssq; float* Dn;
    h16 *W1T, *WABT, *WOT, *U, *PA, *PG, *PP, *PGG, *YAB, *L, *MG; unsigned short* S; unsigned char *U8, *W8T; unsigned* cnt;
};

__device__ __forceinline__ TItem t_decode(const Ptrs& P, int it, int lane) {
    constexpr int I_1 = (D / 64) * (NIN / 32), I_A = (HW / 64) * (D / 32), I_O = (D / 64) * (D / 32);
    const int c4 = 4 * (lane & 7), r8 = lane >> 3;
    TItem t; int r = it;
    t.f8 = 0;
    if (r < 2 * I_A + I_O) {
        const int nb = r % (D / 32), vbase = 32 * nb, col = (vbase + c4 & ~31) + pg8::perm32((vbase + c4) & 31);
        if (r < I_A) { const int kb = r / (D / 32); t.N = D; t.ldk = 4096; t.src = P.w_a + (size_t)(64 * kb + r8) * D + col; t.dst = P.WABT + (size_t)vbase * 4096 + 64 * kb; return t; }
        r -= I_A;
        if (r < I_A) { const int kb = r / (D / 32); t.N = D; t.ldk = 4096; t.src = P.w_b + (size_t)(64 * kb + r8) * D + col; t.dst = P.WABT + (size_t)vbase * 4096 + HW + 64 * kb; return t; }
        r -= I_A;
        { const int kb = r / (D / 32); t.N = D; t.ldk = D; t.src = P.w_out + (size_t)(64 * kb + r8) * D + col; t.dst = P.WOT + (size_t)vbase * D + 64 * kb; return t; }
    }
    r -= 2 * I_A + I_O;
    { const int nb = r % (NIN / 32), kb = r / (NIN / 32), vbase = 32 * nb;
        t.N = NIN; t.ldk = D; t.src = P.w_in + (size_t)(64 * kb + r8) * NIN + w1_col_of(vbase + c4);
        if (vbase < 16384) t.dst = P.W1T + (size_t)vbase * D + 64 * kb;
        else { t.f8 = 1; t.dst = (h16*)(P.W8T + (size_t)(vbase - 16384) * D + 64 * kb); }
        return t; }
}
__device__ __forceinline__ void t_load(const TItem& t, f32x4 (&v)[8]) {
#pragma unroll
    for (int j = 0; j < 8; ++j) v[j] = __builtin_nontemporal_load((const f32x4*)(t.src + (size_t)(8 * j) * t.N));
}
__device__ __forceinline__ void p0_prologue(const Ptrs& P, LAS unsigned char* lds, int vcu, int G, int tid) {
    const int lane = tid & 63, wave = __builtin_amdgcn_readfirstlane(tid >> 6);
    LAS float* scr = (LAS float*)(lds + wave * 16384);
    const int gw = vcu * 8 + wave, NGW = G * 8;
    constexpr int NITEMS = (D / 64) * (NIN / 32) + 2 * (HW / 64) * (D / 32) + (D / 64) * (D / 32);
    if (gw < NITEMS) {
        TItem cur = t_decode(P, gw, lane); f32x4 v[8]; t_load(cur, v);
        for (int it = gw; it < NITEMS; it += NGW) {
            const int nit = it + NGW; const bool has_n = nit < NITEMS;
            f32x4 nv[8];
            const TItem nxt = t_decode(P, has_n ? nit : it, lane); t_load(nxt, nv);
            const int c4 = 4 * (lane & 7), r8 = lane >> 3;
#pragma unroll
            for (int j = 0; j < 8; ++j) { LAS float* d = scr + (8 * j + r8) * 33 + c4; d[0] = v[j][0]; d[1] = v[j][1]; d[2] = v[j][2]; d[3] = v[j][3]; }
            asm volatile("s_waitcnt lgkmcnt(0)" ::: "memory");
            const int c = lane & 7;
            if (cur.f8) {
#pragma unroll
                for (int j = 0; j < 4; ++j) { const int n = (lane >> 3) + 8 * j; const LAS float* sp = scr + (8 * c) * 33 + n;
                    int w0 = 0, w1 = 0;
                    w0 = __builtin_amdgcn_cvt_pk_fp8_f32(sp[0 * 33] * F8_SW, sp[1 * 33] * F8_SW, w0, false); w0 = __builtin_amdgcn_cvt_pk_fp8_f32(sp[2 * 33] * F8_SW, sp[3 * 33] * F8_SW, w0, true);
                    w1 = __builtin_amdgcn_cvt_pk_fp8_f32(sp[4 * 33] * F8_SW, sp[5 * 33] * F8_SW, w1, false); w1 = __builtin_amdgcn_cvt_pk_fp8_f32(sp[6 * 33] * F8_SW, sp[7 * 33] * F8_SW, w1, true);
                    u32x2 o; o.x = (unsigned)w0; o.y = (unsigned)w1;
                    *(u32x2*)((unsigned char*)cur.dst + (size_t)n * cur.ldk + 8 * c) = o; }
            } else {
#pragma unroll
                for (int j = 0; j < 4; ++j) { const int n = (lane >> 3) + 8 * j; const LAS float* sp = scr + (8 * c) * 33 + n;
                    u32x4 o; o.x = pkg(sp[0 * 33], sp[1 * 33]); o.y = pkg(sp[2 * 33], sp[3 * 33]); o.z = pkg(sp[4 * 33], sp[5 * 33]); o.w = pkg(sp[6 * 33], sp[7 * 33]);
                    *(u32x4*)(cur.dst + (size_t)n * cur.ldk + 8 * c) = o; }
            }
            asm volatile("s_waitcnt lgkmcnt(0)" ::: "memory");
#pragma unroll
            for (int j = 0; j < 8; ++j) v[j] = nv[j];
            cur = nxt;
        }
    }
    {
        f32x4 nwv[16];
#pragma unroll
        for (int j = 0; j < 16; ++j) nwv[j] = *((const f32x4*)P.norm_w + lane + 64 * j);
#pragma nounroll
        for (int m = gw; m < T; m += NGW) {
            const f32x4* xr = (const f32x4*)(P.x + (size_t)m * D) + lane;
            f32x4 v[16]; float s = 0.f;
#pragma unroll
            for (int j = 0; j < 16; ++j) v[j] = __builtin_nontemporal_load(xr + 64 * j);
#pragma unroll
            for (int j = 0; j < 16; ++j) s += (v[j][0] * v[j][0] + v[j][1] * v[j][1]) + (v[j][2] * v[j][2] + v[j][3] * v[j][3]);
            const float rs = rsqrtf(wave_sum(s) * (1.f / D) + EPS), s8 = rs * F8_SU;
            u32x2* o = (u32x2*)(P.U + (size_t)m * D) + lane;
            unsigned* o8 = (unsigned*)(P.U8 + (size_t)m * D) + lane;
#pragma unroll
            for (int j = 0; j < 16; ++j) { const f32x4 w = nwv[j]; const float a0 = v[j][0] * w[0], a1 = v[j][1] * w[1], a2 = v[j][2] * w[2], a3 = v[j][3] * w[3];
                u32x2 q; q.x = pkg(a0 * rs, a1 * rs); q.y = pkg(a2 * rs, a3 * rs); o[64 * j] = q;
                int w8 = 0; w8 = __builtin_amdgcn_cvt_pk_fp8_f32(a0 * s8, a1 * s8, w8, false); w8 = __builtin_amdgcn_cvt_pk_fp8_f32(a2 * s8, a3 * s8, w8, true); o8[64 * j] = (unsigned)w8; }
        }
    }
    for (int i = blockIdx.x * 512 + tid; i < T; i += G * 512) P.ssq[i] = 0.f;
}

__device__ __forceinline__ bf16x8 mk_bf16x8(const float (&v)[8]) {
    u32x4 w; w.x = f2bf(v[0]) | (f2bf(v[1]) << 16); w.y = f2bf(v[2]) | (f2bf(v[3]) << 16); w.z = f2bf(v[4]) | (f2bf(v[5]) << 16); w.w = f2bf(v[6]) | (f2bf(v[7]) << 16);
    return __builtin_bit_cast(bf16x8, w);
}
__device__ __forceinline__ void load_vt(const h16* vsrc, LAS unsigned short* VT, int tid) {
#pragma unroll
    for (int rep = 0; rep < 2; ++rep) { const int cidx = tid + 512 * rep, s = cidx >> 4, ec = (cidx & 15) * 8;
        const h16x8 v = *(const h16x8*)(vsrc + (size_t)s * 8192 + ec);
#pragma unroll
        for (int x = 0; x < 8; ++x) VT[(ec + x) * 72 + s] = (unsigned short)f2bf((float)v[x]); }
}

__device__ __forceinline__ void h1_item(const Ptrs& P, LAS unsigned char* lds, int n, int h, int tid) {
    LAS unsigned short* KT = (LAS unsigned short*)lds;
    LAS unsigned short* VT = KT + 128 * 72;
    LAS float* tot = (LAS float*)(VT + 128 * 72);
    const int d = tid & 127, i = tid >> 7, lane = tid & 63, w = tid >> 6, t0 = n * CH;
    const h16* fp = P.PA + (size_t)(t0 + 16 * i) * 8192 + HW + h * HD + d;
    const float l0 = P.lb_logits[h * HD + d], l1 = P.lb_logits[HW + h * HD + d];
    const float oml = 1.f - __builtin_amdgcn_rcpf(1.f + __expf(l1 - l0));
    float kk[16], c[16], run = 0.f;
#pragma unroll
    for (int u = 0; u < 16; ++u) { const float xv = (float)fp[(size_t)u * 8192]; const float k = oml * __builtin_amdgcn_rcpf(1.f + __expf(xv)); run += __logf(1.f - k); kk[u] = k; c[u] = run; }
    tot[i * 128 + d] = run;
    load_vt(P.PA + (size_t)t0 * 8192 + 2 * HW + h * HD, VT, tid);
    __syncthreads();
    float R = 0.f;
#pragma unroll
    for (int j = 1; j < 4; ++j) if (j > i) R += tot[j * 128 + d];
    const float base = R + run;
    float v0[8], v1[8];
#pragma unroll
    for (int u = 0; u < 8; ++u) { v0[u] = kk[u] * __expf(base - c[u]); v1[u] = kk[8 + u] * __expf(base - c[8 + u]); }
    *(LAS bf16x8*)(KT + d * 72 + 16 * i) = mk_bf16x8(v0);
    *(LAS bf16x8*)(KT + d * 72 + 16 * i + 8) = mk_bf16x8(v1);
    if (i == 0) P.Dn[(size_t)(n * NH + h) * HD + d] = __expf(base);
    __syncthreads();
    f32x4 acc[8];
#pragma unroll
    for (int nn = 0; nn < 8; ++nn) acc[nn] = (f32x4){0.f, 0.f, 0.f, 0.f};
#pragma unroll
    for (int k2 = 0; k2 < 2; ++k2) {
        const bf16x8 a = *(const LAS bf16x8*)(VT + (16 * w + (lane & 15)) * 72 + 32 * k2 + 8 * (lane >> 4));
#pragma unroll
        for (int nn = 0; nn < 8; ++nn) { const bf16x8 b = *(const LAS bf16x8*)(KT + (16 * nn + (lane & 15)) * 72 + 32 * k2 + 8 * (lane >> 4));
            acc[nn] = __builtin_amdgcn_mfma_f32_16x16x32_bf16(a, b, acc[nn], 0, 0, 0); }
    }
    h16* Lp = P.L + (size_t)(n * NH + h) * (HD * HD);
#pragma unroll
    for (int nn = 0; nn < 8; ++nn)
#pragma unroll
        for (int j = 0; j < 4; ++j) Lp[(16 * w + 4 * (lane >> 4) + j) * HD + 16 * nn + (lane & 15)] = (h16)acc[nn][j];
    __syncthreads();
}

__device__ __forceinline__ void yb_phase(const Ptrs& P, int G, int tid) {
    for (int it = blockIdx.x * 512 + tid; it < (T / 8) * (HW / 8); it += G * 512) {
        const int c = (it & 255) * 8, t0 = (it >> 8) * 8;
        float w0[8], w1[8], w2[8], pm2[8], pm1[8];
#pragma unroll
        for (int q = 0; q < 2; ++q) { const f32x4 a = *(const f32x4*)(P.conv_w + c + 4 * q), b = *(const f32x4*)(P.conv_w + HW + c + 4 * q), cc = *(const f32x4*)(P.conv_w + 2 * HW + c + 4 * q);
#pragma unroll
            for (int j = 0; j < 4; ++j) { w0[4 * q + j] = a[j]; w1[4 * q + j] = b[j]; w2[4 * q + j] = cc[j]; } }
        if (t0 > 0) { const h16x8 a = *(const h16x8*)(P.PP + (size_t)(t0 - 2) * HW + c), b = *(const h16x8*)(P.PP + (size_t)(t0 - 1) * HW + c);
#pragma unroll
            for (int j = 0; j < 8; ++j) { pm2[j] = (float)a[j]; pm1[j] = (float)b[j]; } }
        else {
#pragma unroll
            for (int j = 0; j < 8; ++j) { pm2[j] = 0.f; pm1[j] = 0.f; } }
        h16x8 pcv[8], ggv[8];
#pragma unroll
        for (int r = 0; r < 8; ++r) { pcv[r] = *(const h16x8*)(P.PP + (size_t)(t0 + r) * HW + c); ggv[r] = *(const h16x8*)(P.PGG + (size_t)(t0 + r) * HW + c); }
#pragma unroll
        for (int r = 0; r < 8; ++r) {
            const h16x8 pc = pcv[r], gg = ggv[r];
            float y[8];
#pragma unroll
            for (int j = 0; j < 8; ++j) { const float pcf = (float)pc[j]; y[j] = (float)gg[j] * (w0[j] * pm2[j] + w1[j] * pm1[j] + w2[j] * pcf); pm2[j] = pm1[j]; pm1[j] = pcf; }
            u32x4 o; o.x = pkg(y[0], y[1]); o.y = pkg(y[2], y[3]); o.z = pkg(y[4], y[5]); o.w = pkg(y[6], y[7]);
            *(u32x4*)(P.YAB + (size_t)(t0 + r) * D + HW + c) = o;
        }
    }
}

__device__ __forceinline__ void h2_phase(const Ptrs& P, int G, int tid) {
    constexpr size_t SLAB = (size_t)NH * HD * HD;
    constexpr int UB = 32;
    for (int idx = blockIdx.x * 512 + tid; idx < NH * HD * (HD / 2); idx += G * 512) {
        const int d2 = idx & 63, e = (idx >> 6) & 127, h = idx >> 13;
        const size_t off = ((size_t)h * HD + e) * HD + 2 * d2;
        float s0 = 0.f, s1 = 0.f;
        for (int nb = 0; nb < NCH; nb += UB) {
            h16x2 l[UB]; f32x2 dd[UB];
#pragma unroll
            for (int q = 0; q < UB; ++q) { l[q] = *(const h16x2*)(P.L + (size_t)(nb + q) * SLAB + off); dd[q] = *(const f32x2*)(P.Dn + (size_t)((nb + q) * NH + h) * HD + 2 * d2); }
#pragma unroll
            for (int q = 0; q < UB; ++q) {
                *(unsigned*)(P.S + (size_t)(nb + q) * SLAB + off) = f2bf(s0) | (f2bf(s1) << 16);
                s0 = dd[q][0] * s0 + (float)l[q][0]; s1 = dd[q][1] * s1 + (float)l[q][1]; }
        }
    }
}

__device__ __forceinline__ unsigned short bf1(float x) { unsigned r; asm("v_cvt_pk_bf16_f32 %0, %1, %1" : "=v"(r) : "v"(x)); return (unsigned short)r; }
__device__ __forceinline__ int vt_idx(int e, int s) { return e * 72 + (s ^ (((e >> 3) & 7) << 3)); }
__device__ __forceinline__ void tile_ld(const h16* src, h16x8 (&r)[2], int tid) {
#pragma unroll
    for (int rep = 0; rep < 2; ++rep) { const int cidx = tid + 512 * rep; r[rep] = *(const h16x8*)(src + (size_t)(cidx >> 4) * 8192 + (cidx & 15) * 8); }
}
__device__ __forceinline__ void tile_st(LAS h16* dst, const h16x8 (&r)[2], int tid) {
#pragma unroll
    for (int rep = 0; rep < 2; ++rep) { const int cidx = tid + 512 * rep; *(LAS h16x8*)(dst + (cidx >> 4) * 128 + (cidx & 15) * 8) = r[rep]; }
}
__device__ __forceinline__ void vt_st(LAS unsigned short* VT, const h16x8 (&r)[2], int tid) {
#pragma unroll
    for (int rep = 0; rep < 2; ++rep) { const int cidx = tid + 512 * rep, sI = cidx >> 4, ec = (cidx & 15) * 8;
#pragma unroll
        for (int x = 0; x < 8; ++x) VT[vt_idx(ec + x, sI)] = bf1((float)r[rep][x]); }
}

__device__ __forceinline__ float row16_sum(float v) {
    v += __builtin_bit_cast(float, __builtin_amdgcn_mov_dpp(__builtin_bit_cast(int, v), 0xB1, 0xF, 0xF, true));
    v += __builtin_bit_cast(float, __builtin_amdgcn_mov_dpp(__builtin_bit_cast(int, v), 0x4E, 0xF, 0xF, true));
    v += __builtin_bit_cast(float, __builtin_amdgcn_mov_dpp(__builtin_bit_cast(int, v), 0x141, 0xF, 0xF, true));
    v += __builtin_bit_cast(float, __builtin_amdgcn_mov_dpp(__builtin_bit_cast(int, v), 0x140, 0xF, 0xF, true));
    return v;
}
__device__ __forceinline__ void h1_phase(const Ptrs& P, LAS unsigned char* lds, int bx, int G, int tid) {
    LAS unsigned short* KT = (LAS unsigned short*)lds;
    LAS unsigned short* VT = KT + 128 * 72;
    LAS float* tot = (LAS float*)(VT + 128 * 72);
    LAS h16* FST = (LAS h16*)(tot + 512);
    LAS h16* LT = FST + 64 * 128;
    const int d = tid & 127, i = __builtin_amdgcn_readfirstlane(tid >> 7), lane = tid & 63, w = __builtin_amdgcn_readfirstlane(tid >> 6);
    const int fr = lane & 15, fq = lane >> 4;
    const int NIT = NCH * NH;
    if (bx >= NIT) return;
    h16x8 pf[2], pv[2];
#define H1_PREFETCH(itn) do { const int n_ = (itn) >> 4, h_ = (itn) & 15; const h16* base_ = P.PA + (size_t)(n_ * CH) * 8192 + h_ * HD; \
        tile_ld(base_ + HW, pf, tid); tile_ld(base_ + 2 * HW, pv, tid); } while (0)
#define H1_FLUSH(itp) do { h16* Lp_ = P.L + (size_t)(itp) * (HD * HD); \
        _Pragma("unroll") for (int rep = 0; rep < 4; ++rep) { const int cidx = tid + 512 * rep; *(h16x8*)(Lp_ + cidx * 8) = *(const LAS h16x8*)(LT + cidx * 8); } } while (0)
    H1_PREFETCH(bx);
    const bool hfix = (G & 15) == 0;
    float l0 = P.lb_logits[(bx & 15) * HD + d], l1 = P.lb_logits[HW + (bx & 15) * HD + d];
    int itprev = -1;
    for (int it = bx; it < NIT; it += G) {
        const int n = it >> 4, h = it & 15;
        if (!hfix) { l0 = P.lb_logits[h * HD + d]; l1 = P.lb_logits[HW + h * HD + d]; }
        tile_st(FST, pf, tid); vt_st(VT, pv, tid);
        __syncthreads();
        const float oml = 1.f - __builtin_amdgcn_rcpf(1.f + __expf(l1 - l0));
        float kk[16], pc[16], run = 1.f;
#pragma unroll
        for (int u = 0; u < 16; ++u) { const float xv = (float)FST[(16 * i + u) * 128 + d]; const float k = oml * __builtin_amdgcn_rcpf(1.f + __expf(xv)); run *= (1.f - k); kk[u] = k; pc[u] = run; }
        tot[i * 128 + d] = run;
        __syncthreads();
        float base = run;
#pragma unroll
        for (int j = 1; j < 4; ++j) if (j > i) base *= tot[j * 128 + d];
        float v0[8], v1[8];
#pragma unroll
        for (int u = 0; u < 8; ++u) { v0[u] = kk[u] * base * __builtin_amdgcn_rcpf(pc[u]); v1[u] = kk[8 + u] * base * __builtin_amdgcn_rcpf(pc[8 + u]); }
        *(LAS bf16x8*)(KT + d * 72 + 16 * i) = mk_bf16x8(v0);
        *(LAS bf16x8*)(KT + d * 72 + 16 * i + 8) = mk_bf16x8(v1);
        if (i == 0) P.Dn[(size_t)it * HD + d] = base;
        if (itprev >= 0) H1_FLUSH(itprev);
        { const int nit = it + G; H1_PREFETCH(nit < NIT ? nit : it); }
        __syncthreads();
        f32x4 acc[8];
#pragma unroll
        for (int nn = 0; nn < 8; ++nn) acc[nn] = (f32x4){0.f, 0.f, 0.f, 0.f};
#pragma unroll
        for (int k2 = 0; k2 < 2; ++k2) {
            const bf16x8 a = *(const LAS bf16x8*)(VT + vt_idx(16 * w + fr, 32 * k2 + 8 * fq));
#pragma unroll
            for (int nn = 0; nn < 8; ++nn) { const bf16x8 b = *(const LAS bf16x8*)(KT + (16 * nn + fr) * 72 + 32 * k2 + 8 * fq);
                acc[nn] = __builtin_amdgcn_mfma_f32_16x16x32_bf16(a, b, acc[nn], 0, 0, 0); }
        }
#pragma unroll
        for (int nn = 0; nn < 8; ++nn)
#pragma unroll
            for (int j = 0; j < 4; ++j) LT[(16 * w + 4 * fq + j) * HD + 16 * nn + fr] = (h16)acc[nn][j];
        itprev = it;
        __syncthreads();
    }
    if (itprev >= 0) H1_FLUSH(itprev);
#undef H1_PREFETCH
#undef H1_FLUSH
}

__device__ __forceinline__ void h3_phase(const Ptrs& P, LAS unsigned char* lds, int bx, int G, int tid) {
    constexpr int QS = 136;
    LAS unsigned short* Q1 = (LAS unsigned short*)lds;
    LAS unsigned short* Q2 = Q1 + 64 * QS;
    LAS unsigned short* KH = Q2 + 64 * QS;
    LAS h16* FST = (LAS h16*)KH;
    LAS h16* QST = FST + 64 * 128;
    LAS unsigned short* Pm = KH + 160 * QS;
    LAS unsigned short* VT = Pm + 64 * 72;
    LAS float* tot = (LAS float*)(VT + 128 * 72);
    LAS float* red = tot + 512;
    LAS h16* GST = (LAS h16*)(red + 512);
    LAS unsigned short* YST = (LAS unsigned short*)(GST + 64 * 128);
    const int d = tid & 127, i = __builtin_amdgcn_readfirstlane(tid >> 7), lane = tid & 63, w = __builtin_amdgcn_readfirstlane(tid >> 6);
    const int fr = lane & 15, fq = lane >> 4;
    const int NIT = NCH * NH;
    if (bx >= NIT) return;
    h16x8 pf[2], pq[2], pv[2], pg[2]; bf16x8 psb[4];
#define H3_PREFETCH(itn) do { const int n_ = (itn) >> 4, h_ = (itn) & 15; const h16* base_ = P.PA + (size_t)(n_ * CH) * 8192 + h_ * HD; \
        tile_ld(base_, pq, tid); tile_ld(base_ + HW, pf, tid); tile_ld(base_ + 2 * HW, pv, tid); tile_ld(base_ + 3 * HW, pg, tid); \
        const unsigned short* Sp_ = P.S + (size_t)(n_ * NH + h_) * (HD * HD) + (16 * w + fr) * HD + 8 * fq; \
        _Pragma("unroll") for (int k2 = 0; k2 < 4; ++k2) psb[k2] = *(const bf16x8*)(Sp_ + 32 * k2); } while (0)
    H3_PREFETCH(bx);
    const bool hfix = (G & 15) == 0;
    float l0 = P.lb_logits[(bx & 15) * HD + d], l1 = P.lb_logits[HW + (bx & 15) * HD + d], nwv = P.hgrn_nw[16 * w + fr];
    size_t yoff = 0; bool have_y = false;
#define H3_FLUSH() do { _Pragma("unroll") for (int rep = 0; rep < 2; ++rep) { const int cidx = tid + 512 * rep; \
        *(u32x4*)((unsigned short*)P.YAB + yoff + (size_t)(cidx >> 4) * D + (cidx & 15) * 8) = *(const LAS u32x4*)(YST + (cidx >> 4) * 128 + (cidx & 15) * 8); } } while (0)
    for (int it = bx; it < NIT; it += G) {
        const int n = it >> 4, h = it & 15, t0 = n * CH;
        if (!hfix) { l0 = P.lb_logits[h * HD + d]; l1 = P.lb_logits[HW + h * HD + d]; }
        tile_st(FST, pf, tid); tile_st(QST, pq, tid); vt_st(VT, pv, tid);
        bf16x8 sb[4];
#pragma unroll
        for (int k2 = 0; k2 < 4; ++k2) sb[k2] = psb[k2];
        __syncthreads();
        const float oml = 1.f - __builtin_amdgcn_rcpf(1.f + __expf(l1 - l0));
        float kk[16], pc[16], qq[16], run = 1.f;
#pragma unroll
        for (int u = 0; u < 16; ++u) { const float xv = (float)FST[(16 * i + u) * 128 + d]; qq[u] = (float)QST[(16 * i + u) * 128 + d];
            const float k = oml * __builtin_amdgcn_rcpf(1.f + __expf(xv)); run *= (1.f - k); kk[u] = k; pc[u] = run; }
        tot[i * 128 + d] = run;
        for (int z = tid; z < 64 * 72 / 8; z += 512) ((LAS u32x4*)Pm)[z] = (u32x4){0u, 0u, 0u, 0u};
        if (tid < 64) red[tid] = 0.f;
        __syncthreads();
        tile_st(GST, pg, tid);
        {
            float tt[4];
#pragma unroll
            for (int j = 0; j < 4; ++j) tt[j] = tot[j * 128 + d];
            float er = 1.f;
#pragma unroll
            for (int j = 0; j < 4; ++j) if (j < i) er *= tt[j];
            float erho[4];
#pragma unroll
            for (int ip = 0; ip < 4; ++ip) { float rho = 1.f;
#pragma unroll
                for (int j = 0; j < 4; ++j) if (j >= i && j < ip) rho *= tt[j];
                erho[ip] = rho; }
            float kd[16];
#pragma unroll
            for (int u = 0; u < 16; ++u) { const int t = 16 * i + u;
                const float q2 = qq[u] * pc[u]; kd[u] = kk[u] * __builtin_amdgcn_rcpf(pc[u]);
                Q2[t * QS + d] = bf1(q2);
                Q1[t * QS + d] = bf1(q2 * er); }
#pragma unroll
            for (int ip = 0; ip < 4; ++ip) {
                if (ip >= i) {
                    const int rb = 8 * ip * (ip + 1) + 16 * i;
#pragma unroll
                    for (int u = 0; u < 16; ++u) KH[(rb + u) * QS + d] = bf1(kd[u] * erho[ip]);
                }
            }
        }
        if (have_y) H3_FLUSH();
        { const int nit = it + G; H3_PREFETCH(nit < NIT ? nit : it); }
        __syncthreads();
        for (int idx = w; idx < 10; idx += 8) {
            const int i2 = idx >= 6 ? 3 : (idx >= 3 ? 2 : (idx >= 1 ? 1 : 0)), j2 = idx - (i2 * (i2 + 1)) / 2;
            f32x4 sc = (f32x4){0.f, 0.f, 0.f, 0.f};
#pragma unroll
            for (int k2 = 0; k2 < 4; ++k2) {
                const bf16x8 a = *(const LAS bf16x8*)(Q2 + (16 * i2 + fr) * QS + 32 * k2 + 8 * fq);
                const bf16x8 b = *(const LAS bf16x8*)(KH + (8 * i2 * (i2 + 1) + 16 * j2 + fr) * QS + 32 * k2 + 8 * fq);
                sc = __builtin_amdgcn_mfma_f32_16x16x32_bf16(a, b, sc, 0, 0, 0);
            }
#pragma unroll
            for (int jj = 0; jj < 4; ++jj) { const int tl = 4 * fq + jj; const float v = (i2 == j2 && fr > tl) ? 0.f : sc[jj];
                Pm[(16 * i2 + tl) * 72 + 16 * j2 + fr] = bf1(v); }
        }
        __syncthreads();
        f32x4 o[4];
#pragma unroll
        for (int m = 0; m < 4; ++m) o[m] = (f32x4){0.f, 0.f, 0.f, 0.f};
#pragma unroll
        for (int k2 = 0; k2 < 4; ++k2)
#pragma unroll
            for (int m = 0; m < 4; ++m) { const bf16x8 a = *(const LAS bf16x8*)(Q1 + (16 * m + fr) * QS + 32 * k2 + 8 * fq);
                o[m] = __builtin_amdgcn_mfma_f32_16x16x32_bf16(a, sb[k2], o[m], 0, 0, 0); }
#pragma unroll
        for (int k2 = 0; k2 < 2; ++k2) { const bf16x8 b = *(const LAS bf16x8*)(VT + vt_idx(16 * w + fr, 32 * k2 + 8 * fq));
#pragma unroll
            for (int m = 0; m < 4; ++m) { if (k2 == 1 && m < 2) continue;
                const bf16x8 a = *(const LAS bf16x8*)(Pm + (16 * m + fr) * 72 + 32 * k2 + 8 * fq);
                o[m] = __builtin_amdgcn_mfma_f32_16x16x32_bf16(a, b, o[m], 0, 0, 0); } }
#pragma unroll
        for (int m = 0; m < 4; ++m)
#pragma unroll
            for (int jj = 0; jj < 4; ++jj) { const float sq = row16_sum(o[m][jj] * o[m][jj]);
                if (fr == 0) __builtin_amdgcn_ds_faddf(red + 16 * m + 4 * fq + jj, sq, 0, 0, false); }
        __syncthreads();
        const int e = 16 * w + fr;
#pragma unroll
        for (int m = 0; m < 4; ++m)
#pragma unroll
            for (int jj = 0; jj < 4; ++jj) { const int t = 16 * m + 4 * fq + jj; const float ss = red[t];
                const float rs = rsqrtf(ss * (1.f / HD) + EPS);
                const float gv = (float)GST[t * 128 + e];
                const float yv = o[m][jj] * rs * nwv * gv * sigmoidf_(gv);
#if GEMM_BF16
                YST[t * 128 + e] = bf1(yv);
#else
                YST[t * 128 + e] = __builtin_bit_cast(unsigned short, (h16)yv);
#endif
            }
        yoff = (size_t)t0 * D + h * HD; have_y = true;
    }
    __syncthreads();
    if (have_y) H3_FLUSH();
#undef H3_FLUSH
#undef H3_PREFETCH
}

__device__ __forceinline__ void final_phase(const Ptrs& P, int G, int tid) {
    const int lane = tid & 63, wave = tid >> 6;
    f32x4 fw[8][2];
#pragma unroll
    for (int j = 0; j < 8; ++j) { fw[j][0] = *(const f32x4*)(P.final_nw + 8 * (lane + 64 * j)); fw[j][1] = *(const f32x4*)(P.final_nw + 8 * (lane + 64 * j) + 4); }
    for (int row = blockIdx.x * 8 + wave; row < T; row += G * 8) {
        const float rs = rsqrtf(P.ssq[row] * (1.f / D) + EPS);
        const h16x8* hp = (const h16x8*)(P.U + (size_t)row * D) + lane;
        h16x8 hv[8];
#pragma unroll
        for (int j = 0; j < 8; ++j) hv[j] = hp[64 * j];
        f32x4* o = (f32x4*)(P.out + (size_t)row * D) + 2 * lane;
#pragma unroll
        for (int j = 0; j < 8; ++j) {
            f32x4 a0, a1;
#pragma unroll
            for (int q = 0; q < 4; ++q) { a0[q] = (float)hv[j][q] * rs * fw[j][0][q]; a1[q] = (float)hv[j][4 + q] * rs * fw[j][1][q]; }
            o[128 * j] = a0; o[128 * j + 1] = a1; }
    }
}

__device__ __forceinline__ unsigned long long ldptr(LAS const unsigned long long* pt, int k) {
    const unsigned long long v = pt[k]; const unsigned lo = __builtin_amdgcn_readfirstlane((unsigned)v), hi = __builtin_amdgcn_readfirstlane((unsigned)(v >> 32));
    return ((unsigned long long)hi << 32) | lo;
}
#define GAS __attribute__((address_space(1)))
#define GP(T, v) ((T*)(GAS T*)(v))
__device__ __forceinline__ Ptrs mkptrs(LAS const unsigned long long* pt) {
    Ptrs P;
    P.x = GP(const float, ldptr(pt, 0)); P.norm_w = GP(const float, ldptr(pt, 1)); P.w_in = GP(const float, ldptr(pt, 2)); P.lb_logits = GP(const float, ldptr(pt, 3)); P.hgrn_nw = GP(const float, ldptr(pt, 4));
    P.conv_w = GP(const float, ldptr(pt, 5)); P.w_a = GP(const float, ldptr(pt, 6)); P.w_b = GP(const float, ldptr(pt, 7)); P.gate_bias = GP(const float, ldptr(pt, 8)); P.w_out = GP(const float, ldptr(pt, 9));
    P.final_nw = GP(const float, ldptr(pt, 10)); P.out = GP(float, ldptr(pt, 11));
    const unsigned long long ws = ldptr(pt, 12);
    P.ssq = GP(float, ws + WS_SSQ); P.Dn = GP(float, ws + WS_DN);
    P.W1T = GP(h16, ws + WS_W1T); P.WABT = GP(h16, ws + WS_WABT); P.WOT = GP(h16, ws + WS_WOT); P.U = GP(h16, ws + WS_U);
    P.PA = GP(h16, ws + WS_PA); P.PG = GP(h16, ws + WS_PG); P.PP = GP(h16, ws + WS_PP); P.PGG = GP(h16, ws + WS_PGG);
    P.YAB = GP(h16, ws + WS_YAB); P.L = GP(h16, ws + WS_L); P.S = GP(unsigned short, ws + WS_S); P.MG = GP(h16, ws + WS_MG); P.U8 = GP(unsigned char, ws + WS_U8); P.W8T = GP(unsigned char, ws + WS_W8T); P.cnt = GP(unsigned, ws + WS_CNT);
    return P;
}


#define XB_TMO      128
#define XB_XCNT(j)  (256  + 64 * (j))
#define XB_XSUB(j)  (1280 + 64 * (j))
#define XB_XGEN(j)  (2304 + 64 * (j))
#define XB_TOP      3328
#define XB_TOPGEN   3392
#define XCD_BAR_WORDS 3456
#define XB_SPIN_CAP (1u << 22)
__device__ __forceinline__ unsigned xb_ld(unsigned* p)              { return __hip_atomic_load(p, __ATOMIC_RELAXED, __HIP_MEMORY_SCOPE_AGENT); }
__device__ __forceinline__ unsigned xb_add(unsigned* p, unsigned v) { return __hip_atomic_fetch_add(p, v, __ATOMIC_RELAXED, __HIP_MEMORY_SCOPE_AGENT); }
__device__ __forceinline__ unsigned xb_xcc_id() { return (unsigned)__builtin_amdgcn_s_getreg((3 << 11) | 20) & 0xFu; }
#define XB_SPIN(cond, bar) do { unsigned _sp = 0; while (cond) { __builtin_amdgcn_s_sleep(1); \
    if ((++_sp & 255u) == 0u) { if (xb_ld(&(bar)[XB_TMO])) break; if (_sp > XB_SPIN_CAP) { atomicAdd(&(bar)[XB_TMO], 1u); break; } } } } while (0)
__device__ __forceinline__ void xcd_barrier_complete(unsigned* bar, unsigned x, unsigned& nloc, unsigned& nx) {
    const unsigned G = gridDim.x;
    unsigned sum, cnt, mine, sp = 0u;
    for (;;) {
        sum = 0u; cnt = 0u; mine = 0u;
#pragma unroll
        for (unsigned j = 0; j < 16; ++j) { const unsigned c = xb_ld(&bar[XB_XCNT(j)]); sum += c; cnt += (c > 0u) ? 1u : 0u; mine = (j == x) ? c : mine; }
        if (sum == G) break;
        __builtin_amdgcn_s_sleep(1);
        if ((++sp & 255u) == 0u) { if (xb_ld(&bar[XB_TMO])) break; if (sp > XB_SPIN_CAP) { atomicAdd(&bar[XB_TMO], 1u); break; } }
    }
    nloc = mine > 0u ? mine : 1u; nx = cnt > 0u ? cnt : 1u;
}
__device__ __forceinline__ void xcd_barrier(unsigned* bar, volatile LAS unsigned* st, bool is_t0) {
    asm volatile("s_waitcnt vmcnt(0)" ::: "memory");
    __syncthreads();
    if (is_t0) {
        __builtin_amdgcn_s_waitcnt(0);
        const unsigned x = xb_xcc_id();
        unsigned nloc = st[0], nx = st[1];
        if (nloc == 0u) { xcd_barrier_complete(bar, x, nloc, nx); st[0] = nloc; st[1] = nx; }
        const unsigned old = xb_add(&bar[XB_XSUB(x)], 1u);
        const unsigned gen = old / nloc;
        if (old + 1u == (gen + 1u) * nloc) {
            __builtin_amdgcn_fence(__ATOMIC_RELEASE, "agent");
            asm volatile("s_waitcnt vmcnt(0)" ::: "memory");
            const unsigned og = xb_add(&bar[XB_TOP], 1u);
            const unsigned tg = og / nx;
            if (og + 1u == (tg + 1u) * nx) xb_add(&bar[XB_TOPGEN], 1u);
            else XB_SPIN(xb_ld(&bar[XB_TOPGEN]) == tg, bar);
            __builtin_amdgcn_fence(__ATOMIC_ACQUIRE, "agent");
            xb_add(&bar[XB_XGEN(x)], 1u);
            asm volatile("s_waitcnt vmcnt(0)" ::: "memory");
        } else {
            XB_SPIN(xb_ld(&bar[XB_XGEN(x)]) == gen, bar);
            __builtin_amdgcn_fence(__ATOMIC_ACQUIRE, "agent");
            asm volatile("s_waitcnt vmcnt(0)" ::: "memory");
        }
    }
    __syncthreads();
}

struct Args { const float* in[11]; float* out; unsigned char* ws; int ph_lo, ph_hi; };
constexpr int NPH = 8;

template <int COOP>
__global__ void __launch_bounds__(512, 2) mega(Args a) {
    extern __shared__ __attribute__((aligned(16))) unsigned char lds_raw[];
    LAS unsigned char* lds = (LAS unsigned char*)lds_raw;
    const int G = gridDim.x, bx = blockIdx.x, wave0 = __builtin_amdgcn_readfirstlane((int)threadIdx.x >> 6);
    const int vcu = (G % 8 == 0) ? (bx % 8) * (G / 8) + bx / 8 : bx;
    LAS unsigned long long* ptab = (LAS unsigned long long*)(lds + LDS_CTL);
    { const int t0_ = fresh_tid(); if (t0_ < 13) ptab[t0_] = (t0_ < 11) ? (unsigned long long)a.in[t0_] : (t0_ == 11 ? (unsigned long long)a.out : (unsigned long long)a.ws); }
    volatile LAS unsigned* xst = (volatile LAS unsigned*)(lds + LDS_CTL + 128);
    unsigned* xbar = nullptr;
    if constexpr (COOP) {
        xbar = GP(unsigned, (unsigned long long)a.ws + WS_BAR);
        if (lane_id_fresh() == 0 && wave0 == 0) { xst[0] = 0u; xst[1] = 0u; (void)xb_add(&xbar[XB_XCNT(xb_xcc_id())], 1u); }
    }
    __syncthreads();
    const int lo = a.ph_lo, hi = a.ph_hi;
#define IN(k) (((PHMASK >> (k)) & 1) && (COOP || (lo <= (k) && (k) < hi)))
#ifndef CG_SEAM
#define CG_SEAM 0
#endif
#define SEAM(k) do { if constexpr (COOP) { if (IN(k) && IN((k) + 1)) { if ((k) == CG_SEAM) cg::this_grid().sync(); else xcd_barrier(xbar, xst, lane_id_fresh() == 0 && wave0 == 0); } } } while (0)

    if (IN(0)) REP(0) { const Ptrs P = mkptrs(ptab); p0_prologue(P, lds, vcu, G, fresh_tid()); }
    SEAM(0);
    if (IN(1)) REP(1) { const Ptrs P = mkptrs(ptab);
#ifndef NO_G1A
        { pg8::Gemm g{P.U, P.W1T, T, 16384, D, D}; pg8::StaticOrder S; S.init(T, 16384, G, bx);
          pg8::EpiG1 E{P.PA, P.PP, P.PGG};
          pg8::gemm_phase<pg8::EpiG1, pg8::StaticOrder, false>(lds, g, S, E, fresh_tid()); }
#endif
#ifndef NO_G1B
        { pg8::Gemm g{P.U8, P.W8T, T, 8192, D / 2, D / 2}; pg8::StaticOrder S; S.init(T, 8192, G, bx);
          pg8::EpiGate E{P.PG, P.gate_bias};
          pg8::gemm_phase<pg8::EpiGate, pg8::StaticOrder, true>(lds, g, S, E, fresh_tid()); }
#endif
    }
    SEAM(1);
    if (IN(2)) REP(2) { const Ptrs P = mkptrs(ptab);
        h1_phase(P, lds, bx, G, fresh_tid());
        __syncthreads();
        yb_phase(P, G, fresh_tid());
    }
    SEAM(2);
    if (IN(3)) REP(3) { const Ptrs P = mkptrs(ptab); h2_phase(P, G, fresh_tid()); }
    SEAM(3);
    if (IN(4)) REP(4) { const Ptrs P = mkptrs(ptab);
        h3_phase(P, lds, bx, G, fresh_tid());
        __syncthreads();
    }
    SEAM(4);
    if (IN(5)) REP(5) { const Ptrs P = mkptrs(ptab);
        pg8::Gemm g{P.YAB, P.WABT, T, D, 4096, HW}; pg8::StaticOrder S; S.init(T, D, G, bx, 2, 4);
        pg8::EpiG2 E{P.PG, P.MG};
        pg8::gemm_phase(lds, g, S, E, fresh_tid());
    }
    SEAM(5);
    if (IN(6)) { const Ptrs P = mkptrs(ptab);
        pg8::Gemm g{P.MG, P.WOT, T, D, D, D}; pg8::StaticOrder S; S.init(T, D, G, bx, 1, 4);
        pg8::EpiG3 E{P.x, P.U, P.ssq, P.cnt};
        pg8::gemm_phase(lds, g, S, E, fresh_tid());
        if constexpr (COOP) {
            const int tid = fresh_tid(); pg8::Unit u;
            for (int ui = 0; S.next(ui, u); ++ui) pg8::final_tile(u, P.U, P.ssq, P.cnt, P.final_nw, P.out, tid);
        }
    }
    if constexpr (!COOP) { if (IN(7)) { const Ptrs P = mkptrs(ptab); final_phase(P, G, fresh_tid()); } }
#undef IN
#undef SEAM
}

extern "C" void kernel_launch(void* const* d_in, const int* in_sizes, int n_in, void* d_out, int out_size, void* d_ws, size_t ws_size, hipStream_t stream) {
    static int grid = 0;
    if (grid == 0) {
        if (n_in != 11 || in_sizes[0] != T * D || out_size != T * D || ws_size < WS_END) { fprintf(stderr, "kernel_launch: unexpected shapes / workspace (n_in %d, ws %zu, need %zu)\n", n_in, ws_size, (size_t)WS_END); grid = -1; return; }
        int dev = 0, cus = 0, per_cu = 0;
        (void)hipGetDevice(&dev); (void)hipDeviceGetAttribute(&cus, hipDeviceAttributeMultiprocessorCount, dev);
        constexpr int KCOOP = (N_LAUNCHES == 1) ? 1 : 0;
        (void)hipFuncSetAttribute((const void*)mega<KCOOP>, hipFuncAttributeMaxDynamicSharedMemorySize, LDS_BYTES);
        if (hipOccupancyMaxActiveBlocksPerMultiprocessor(&per_cu, (const void*)mega<KCOOP>, 512, LDS_BYTES) != hipSuccess || per_cu < 1) { fprintf(stderr, "kernel_launch: occupancy query failed (%d)\n", per_cu); (void)hipGetLastError(); grid = -1; return; }
        grid = cus * 1;
        if (grid <= 0) grid = 256;
    }
    if (grid < 0) return;
    Args a{};
    for (int i = 0; i < 11; ++i) a.in[i] = (const float*)d_in[i];
    a.out = (float*)d_out; a.ws = (unsigned char*)d_ws;
#if N_LAUNCHES == 1
    (void)hipMemsetAsync((char*)d_ws + WS_BAR, 0, 16384 + 32 * 256, stream);
    a.ph_lo = 0; a.ph_hi = NPH;
    void* args[] = {&a};
    hipError_t e = hipLaunchCooperativeKernel((const void*)mega<1>, dim3(grid), dim3(512), args, LDS_BYTES, stream);
    if (e != hipSuccess) fprintf(stderr, "cooperative launch failed: %s (grid %d)\n", hipGetErrorString(e), grid);
#else
    for (int p = 0; p < NPH; ++p) { a.ph_lo = p; a.ph_hi = p + 1; hipLaunchKernelGGL(mega<0>, dim3(grid), dim3(512), LDS_BYTES, stream, a); }
#endif
}
```

```cpp
#include <hip/hip_runtime.h>
#include <hip/hip_cooperative_groups.h>
#include <cstdio>
#include <cstdint>
namespace cg = cooperative_groups;

#ifndef N_LAUNCHES
#define N_LAUNCHES 1
#endif

#ifndef PHMASK
#define PHMASK 255
#endif
#ifndef ORDER_SHARED_B
#define ORDER_SHARED_B 0
#endif
#ifndef REPMASK
#define REPMASK 0
#endif
#define REP(k) for (int rep_ = 0; rep_ < (((REPMASK >> (k)) & 1) ? 2 : 1); ++rep_)
#define LAS __attribute__((address_space(3)))
typedef _Float16 h16;
typedef _Float16 h16x8 __attribute__((ext_vector_type(8)));
typedef _Float16 h16x4 __attribute__((ext_vector_type(4)));
typedef _Float16 h16x2 __attribute__((ext_vector_type(2)));
typedef short bf16x8 __attribute__((ext_vector_type(8)));
typedef float f32x4 __attribute__((ext_vector_type(4)));
typedef float f32x2 __attribute__((ext_vector_type(2)));
typedef unsigned u32x4 __attribute__((ext_vector_type(4)));
typedef unsigned u32x2 __attribute__((ext_vector_type(2)));
typedef int i32x8 __attribute__((ext_vector_type(8)));
typedef int i32x4 __attribute__((ext_vector_type(4)));

constexpr int T = 8192, D = 4096, NIN = 24576, HW = 2048, NH = 16, HD = 128, CH = 64, NCH = T / CH;
constexpr float EPS = 1e-6f;

constexpr size_t MiB = 1u << 20;
constexpr size_t WS_SSQ = 0;
constexpr size_t WS_BAR = 65536;
constexpr size_t WS_CNT = WS_BAR + 16384;
constexpr size_t WS_DN = 1 * MiB;
constexpr size_t WS_W1T = 2 * MiB;
constexpr size_t WS_WABT = WS_W1T + 192 * MiB;
constexpr size_t WS_WOT = WS_WABT + 32 * MiB;
constexpr size_t WS_U = WS_WOT + 32 * MiB;
constexpr size_t WS_PA = WS_U + 64 * MiB;
constexpr size_t WS_PG = WS_PA + 128 * MiB;
constexpr size_t WS_PP = WS_PG + 128 * MiB;
constexpr size_t WS_PGG = WS_PP + 32 * MiB;
constexpr size_t WS_YAB = WS_PGG + 32 * MiB;
constexpr size_t WS_L = WS_YAB + 64 * MiB;
constexpr size_t WS_S = WS_L + 64 * MiB;
constexpr size_t WS_MG = WS_S + 64 * MiB;
constexpr size_t WS_U8 = WS_MG + 64 * MiB;
constexpr size_t WS_W8T = WS_U8 + 32 * MiB;
constexpr size_t WS_END = WS_W8T + 32 * MiB;
constexpr float F8_SU = 8.f, F8_SW = 256.f;

constexpr int LDS_CTL = 147456;
constexpr int LDS_BYTES = LDS_CTL + 256;

__device__ __forceinline__ unsigned f2bf(float f) { unsigned u = __builtin_bit_cast(unsigned, f); return (u + 0x7fffu + ((u >> 16) & 1u)) >> 16; }
__device__ __forceinline__ unsigned pkh(float lo, float hi) { h16x2 v; v.x = (h16)lo; v.y = (h16)hi; return __builtin_bit_cast(unsigned, v); }
#ifndef GEMM_BF16
#define GEMM_BF16 1
#endif
__device__ __forceinline__ unsigned pkg(float lo, float hi) {
#if GEMM_BF16
    unsigned r; asm("v_cvt_pk_bf16_f32 %0, %1, %2" : "=v"(r) : "v"(lo), "v"(hi)); return r;
#else
    return pkh(lo, hi);
#endif
}
__device__ __forceinline__ float wave_sum(float v) {
#pragma unroll
    for (int o = 1; o < 64; o <<= 1) v += __shfl_xor(v, o);
    return v;
}
__device__ __forceinline__ int lane_id_fresh() { int t; asm volatile("v_mbcnt_lo_u32_b32 %0, -1, 0\n\tv_mbcnt_hi_u32_b32 %0, -1, %0" : "=v"(t)); return t; }
#define fresh_tid() ((wave0 << 6) | lane_id_fresh())
__device__ __forceinline__ float sigmoidf_(float x) { return __builtin_amdgcn_rcpf(1.f + __expf(-x)); }

namespace pg8 {
constexpr int BM = 256, BK = 64, HALF = 128, HTB = HALF * BK * 2, STAGE_BYTES = 8 * HTB, NXCD = 8, WGM = 8;
__host__ __device__ __forceinline__ int lds_byte(int r, int c) { const int st = (r >> 4) * 2 + (c >> 5), rr = r & 15, cc = c & 31, ob = rr * 64 + cc * 2; return st * 1024 + (ob ^ (((ob >> 9) & 1) << 5)); }
__host__ __device__ __forceinline__ void stage_rc(int b, int& R, int& C) { const int st = b / 1024, sb = b % 1024, swz = sb ^ (((sb >> 9) & 1) << 5); R = (st >> 1) * 16 + swz / 64; C = (st & 1) * 32 + (swz % 64) / 2; }
__host__ __device__ __forceinline__ int perm32(int rho) { const int n = rho >> 4, i = rho & 15; return 8 * (i >> 2) + 4 * n + (i & 3); }

struct Unit { int pm, pn, half; };
struct Gemm { const void* A; const void* Bt; int M, N, K, Kloop; };
struct StaticOrder {
    int nM, nN, nwg, G, c, halves, wgm;
    __device__ void init(int M, int N, int G_, int c_, int halves_ = 1, int wgm_ = WGM) { nM = M / BM; nN = N / BM; nwg = nM * nN; G = G_; c = c_; halves = halves_; wgm = wgm_; }
    __device__ bool next(int i, Unit& u) const {
        const int ti = halves == 2 ? (i >> 1) : i; u.half = halves == 2 ? (i & 1) : 0;
#if ORDER_SHARED_B
        if (G == 256 && nM == 32 && (nN & 7) == 0) {
            if (ti >= (nN >> 3)) return false;
            const int x = c & 7, j = c >> 3; u.pm = 4 * x + (j & 3); u.pn = 8 * ti + (j >> 2); return true;
        }
#endif
        const long L = (long)ti * G + c; if (L >= nwg) return false;
        int wgid = (int)L; { const int q = nwg / NXCD, r = nwg % NXCD, xcd = wgid % NXCD, off = wgid / NXCD; wgid = (xcd < r ? xcd * (q + 1) : r * (q + 1) + (xcd - r) * q) + off; }
        const int nig = wgm * nN, gid = wgid / nig, fm = gid * wgm, gsz = (nM - fm) < wgm ? (nM - fm) : wgm;
        u.pm = fm + ((wgid % nig) % gsz); u.pn = (wgid % nig) / gsz; return true;
    }
};

template <class Epi, class Sched, bool FP8 = false>
__device__ __forceinline__ void gemm_phase(LAS unsigned char* lds, const Gemm g, const Sched& S, const Epi& E, const int tid) {
    const int wid = __builtin_amdgcn_readfirstlane(tid >> 6), lane = tid & 63, wr = wid >> 2, wc = wid & 3, fr = lane & 15, fq = lane >> 4;
    const int K = g.K, nt = g.Kloop / BK;
    const size_t halfb = (size_t)g.Kloop * 2;
    const int sc8 = 0x7f7f7f7f;
    unsigned voffA[2];
#pragma unroll
    for (int i = 0; i < 2; ++i) { int R, C; stage_rc(tid * 16 + i * 8192, R, C); voffA[i] = (unsigned)(R * K + C) * 2u; }
    const size_t kstep = (size_t)(BK * 2);
    const size_t hstep = (size_t)HALF * K * 2;
    const size_t tstep = 2 * hstep;
    const unsigned ldsw = (unsigned)wid * 1024u;
    const int aoff = lds_byte(wr * 64 + fr, fq * 8), boff = lds_byte(wc * 32 + fr, fq * 8);
#define PG8_SA(b, h) (((b) * 2 + (h)) * HTB)
#define PG8_SB(b, h) ((4 + (b) * 2 + (h)) * HTB)
#define PG8_STAGE(bufoff, gbase) do { _Pragma("unroll") for (int _i = 0; _i < 2; ++_i) \
        __builtin_amdgcn_global_load_lds((const unsigned*)((const char*)(gbase) + voffA[_i]), (LAS unsigned*)(lds + (bufoff) + ldsw + _i * 8192), 16, 0, 0); } while (0)
#define PG8_LDA(dst, b, h) do { _Pragma("unroll") for (int m = 0; m < 4; ++m) _Pragma("unroll") for (int k = 0; k < 2; ++k) dst[m][k] = *(const LAS h16x8*)(lds + PG8_SA(b, h) + aoff + m * 2048 + k * 1024); } while (0)
#define PG8_LDB(dst, b, h) do { _Pragma("unroll") for (int n = 0; n < 2; ++n) _Pragma("unroll") for (int k = 0; k < 2; ++k) dst[n][k] = *(const LAS h16x8*)(lds + PG8_SB(b, h) + boff + n * 2048 + k * 1024); } while (0)
#define PG8_MMA(ai, bj, At, Bt) do { __builtin_amdgcn_s_setprio(1); _Pragma("unroll") for (int m = 0; m < 4; ++m) _Pragma("unroll") for (int n = 0; n < 2; ++n) { \
        if constexpr (FP8) { const i32x8 b8_ = __builtin_shufflevector(__builtin_bit_cast(i32x4, Bt[n][0]), __builtin_bit_cast(i32x4, Bt[n][1]), 0, 1, 2, 3, 4, 5, 6, 7); \
            const i32x8 a8_ = __builtin_shufflevector(__builtin_bit_cast(i32x4, At[m][0]), __builtin_bit_cast(i32x4, At[m][1]), 0, 1, 2, 3, 4, 5, 6, 7); \
            asm volatile("v_mfma_scale_f32_16x16x128_f8f6f4 %0, %1, %2, %0, %3, %3 op_sel_hi:[0,0,0]" : "+v"(acc[ai][bj][m][n]) : "v"(b8_), "v"(a8_), "v"(sc8)); } \
        else { _Pragma("unroll") for (int k = 0; k < 2; ++k) acc[ai][bj][m][n] = PG8_MFMA(Bt[n][k], At[m][k], acc[ai][bj][m][n]); } } \
        __builtin_amdgcn_s_setprio(0); } while (0)
#if GEMM_BF16
#define PG8_MFMA(a, b, c) __builtin_amdgcn_mfma_f32_16x16x32_bf16(__builtin_bit_cast(bf16x8, a), __builtin_bit_cast(bf16x8, b), c, 0, 0, 0)
#else
#define PG8_MFMA(a, b, c) __builtin_amdgcn_mfma_f32_16x16x32_f16(a, b, c, 0, 0, 0)
#endif
#define PG8_WAIT_V(n) asm volatile("s_waitcnt vmcnt(" #n ")" ::: "memory")
#define PG8_WAIT_L(n) asm volatile("s_waitcnt lgkmcnt(" #n ")" ::: "memory")
#define PG8_BAR __builtin_amdgcn_s_barrier()
#define PG8_SCHED __builtin_amdgcn_sched_barrier(0)
    Unit cur, nxt; int ui = 0;
    if (!S.next(0, cur)) return;
    f32x4 acc[2][2][4][2];
#pragma unroll
    for (int a = 0; a < 2; ++a)
#pragma unroll
        for (int b = 0; b < 2; ++b)
#pragma unroll
            for (int m = 0; m < 4; ++m)
#pragma unroll
                for (int n = 0; n < 2; ++n) acc[a][b][m][n] = (f32x4){0.f, 0.f, 0.f, 0.f};
    h16x8 At[4][2], B0[2][2], B1[2][2];
    const char* cA = (const char*)g.A + (size_t)cur.pm * tstep + cur.half * halfb; const char* cB = (const char*)g.Bt + (size_t)cur.pn * tstep + cur.half * halfb;
    PG8_STAGE(PG8_SB(0, 0), cB); PG8_STAGE(PG8_SB(0, 1), cB + hstep); PG8_STAGE(PG8_SA(0, 0), cA); PG8_STAGE(PG8_SA(0, 1), cA + hstep);
    if (wr == 1) PG8_BAR;
    PG8_WAIT_V(2); PG8_BAR;
    PG8_STAGE(PG8_SB(1, 0), cB + kstep); PG8_STAGE(PG8_SA(1, 0), cA + kstep); PG8_STAGE(PG8_SB(1, 1), cB + hstep + kstep);
    PG8_WAIT_V(6); PG8_BAR;
    for (;;) {
        const bool has_next = S.next(ui + 1, nxt);
        const char* nA = has_next ? (const char*)g.A + (size_t)nxt.pm * tstep + nxt.half * halfb : cA; const char* nB = has_next ? (const char*)g.Bt + (size_t)nxt.pn * tstep + nxt.half * halfb : cB;
#define PG8_KBODY(t) do { \
            const bool last = (t == nt - 2); \
            const char* a1 = cA + (size_t)(t + 1) * kstep; \
            const char* a2 = last ? nA : cA + (size_t)(t + 2) * kstep; const char* b2 = last ? nB : cB + (size_t)(t + 2) * kstep; \
            const char* a3 = a2 + kstep; const char* b3 = b2 + kstep; \
            PG8_LDB(B0, 0, 0); PG8_LDB(B1, 0, 1); PG8_SCHED; PG8_LDA(At, 0, 0); PG8_STAGE(PG8_SA(1, 1), a1 + hstep); \
            PG8_WAIT_V(8); PG8_WAIT_L(0); PG8_BAR; PG8_MMA(0, 0, At, B0); PG8_MMA(0, 1, At, B1); PG8_BAR; PG8_SCHED; \
            PG8_LDA(At, 0, 1); PG8_STAGE(PG8_SB(0, 0), b2); PG8_STAGE(PG8_SB(0, 1), b2 + hstep); PG8_STAGE(PG8_SA(0, 0), a2); \
            PG8_WAIT_V(8); PG8_WAIT_L(0); PG8_BAR; PG8_MMA(1, 0, At, B0); PG8_MMA(1, 1, At, B1); PG8_BAR; PG8_SCHED; \
            PG8_LDB(B0, 1, 0); PG8_LDB(B1, 1, 1); PG8_SCHED; PG8_LDA(At, 1, 0); PG8_STAGE(PG8_SA(0, 1), a2 + hstep); \
            PG8_WAIT_V(8); PG8_WAIT_L(0); PG8_BAR; PG8_MMA(0, 0, At, B0); PG8_MMA(0, 1, At, B1); PG8_BAR; PG8_SCHED; \
            PG8_LDA(At, 1, 1); PG8_STAGE(PG8_SB(1, 0), b3); PG8_STAGE(PG8_SB(1, 1), b3 + hstep); PG8_STAGE(PG8_SA(1, 0), a3); \
            PG8_WAIT_V(8); PG8_WAIT_L(0); PG8_BAR; PG8_MMA(1, 0, At, B0); PG8_MMA(1, 1, At, B1); PG8_BAR; PG8_SCHED; \
        } while (0)
        for (int t = 0; t < nt; t += 2) PG8_KBODY(t);
#undef PG8_KBODY
        if (wr == 0) PG8_BAR;
        if constexpr (FP8) asm volatile("s_nop 15\n\ts_nop 15" ::: "memory");
        E(acc, cur, wr, wc, fr, fq);
        if (!has_next) break;
        if (!Epi::MID || cur.half == 1)
#pragma unroll
        for (int a = 0; a < 2; ++a)
#pragma unroll
            for (int b = 0; b < 2; ++b)
#pragma unroll
                for (int m = 0; m < 4; ++m)
#pragma unroll
                    for (int n = 0; n < 2; ++n) acc[a][b][m][n] = (f32x4){0.f, 0.f, 0.f, 0.f};
        cur = nxt; cA = nA; cB = nB; ++ui;
        if (wr == 1) PG8_BAR;
    }
    PG8_WAIT_V(0);
    PG8_BAR;
#undef PG8_SA
#undef PG8_SB
#undef PG8_STAGE
#undef PG8_LDA
#undef PG8_LDB
#undef PG8_MMA
#undef PG8_MFMA
#undef PG8_WAIT_V
#undef PG8_WAIT_L
#undef PG8_BAR
#undef PG8_SCHED
}

struct EpiG1 {
    static constexpr bool MID = false;
    h16* PA; h16* PP; h16* PGG;
    __device__ __forceinline__ void operator()(const f32x4 (&acc)[2][2][4][2], const Unit& u, int wr, int wc, int fr, int fq) const {
        const int row0 = u.pm * BM + wr * 64 + fr;
        if ((u.pn & 1) == 0) {
            h16* base = PA + 256 * (u.pn >> 1) + wc * 32 + 8 * fq;
#pragma unroll
            for (int ai = 0; ai < 2; ++ai)
#pragma unroll
                for (int m = 0; m < 4; ++m) { h16* rowp = base + (size_t)(row0 + ai * HALF + m * 16) * 8192;
#pragma unroll
                    for (int bj = 0; bj < 2; ++bj) { const f32x4 v0 = acc[ai][bj][m][0], v1 = acc[ai][bj][m][1];
                        u32x4 w; w.x = pkh(v0[0], v0[1]); w.y = pkh(v0[2], v0[3]); w.z = pkh(v1[0], v1[1]); w.w = pkh(v1[2], v1[3]);
                        *(u32x4*)(rowp + bj * HALF) = w; } }
        } else {
            const int ti = u.pn >> 1, c0 = 128 * (ti >> 1) + 32 * wc + 8 * fq;
            h16* dst = (ti & 1) ? PGG : PP;
#pragma unroll
            for (int ai = 0; ai < 2; ++ai)
#pragma unroll
                for (int m = 0; m < 4; ++m) { const size_t off = (size_t)(row0 + ai * HALF + m * 16) * HW + c0;
                    float o[8];
                    if (ti & 1) {
#pragma unroll
                        for (int n = 0; n < 2; ++n)
#pragma unroll
                            for (int j = 0; j < 4; ++j) { const float g = acc[ai][1][m][n][j]; o[4 * n + j] = acc[ai][0][m][n][j] * g * sigmoidf_(g); }
                    } else {
#pragma unroll
                        for (int n = 0; n < 2; ++n)
#pragma unroll
                            for (int j = 0; j < 4; ++j) o[4 * n + j] = acc[ai][0][m][n][j] * acc[ai][1][m][n][j];
                    }
                    u32x4 w; w.x = pkh(o[0], o[1]); w.y = pkh(o[2], o[3]); w.z = pkh(o[4], o[5]); w.w = pkh(o[6], o[7]);
                    *(u32x4*)(dst + off) = w; }
        }
    }
};
struct EpiGate {
    static constexpr bool MID = false;
    h16* PG; const float* gbias;
    __device__ __forceinline__ void operator()(const f32x4 (&acc)[2][2][4][2], const Unit& u, int wr, int wc, int fr, int fq) const {
        const int row0 = u.pm * BM + wr * 64 + fr;
        const int c0 = u.pn * 128 + 32 * wc + 8 * fq;
        constexpr float DS = 1.f / (F8_SU * F8_SW);
        f32x4 ba[2], bb[2];
#pragma unroll
        for (int n = 0; n < 2; ++n) { ba[n] = *(const f32x4*)(gbias + c0 + 4 * n); bb[n] = *(const f32x4*)(gbias + D + c0 + 4 * n); }
#pragma unroll
        for (int ai = 0; ai < 2; ++ai)
#pragma unroll
            for (int m = 0; m < 4; ++m) {
                h16* rowp = PG + (size_t)(u.pm * 32 + u.pn) * 65536 + (ai * 4 + m) * 4096 + (wr * 4 + wc) * 512 + (fq * 16 + fr) * 8;
                float r[8], sg[8];
#pragma unroll
                for (int n = 0; n < 2; ++n)
#pragma unroll
                    for (int j = 0; j < 4; ++j) { const float ea = __expf(-(acc[ai][0][m][n][j] * DS + ba[n][j])), eb = __expf(-(acc[ai][1][m][n][j] * DS + bb[n][j]));
                        const float pa = 1.f + ea, pb = 1.f + eb, rp = __builtin_amdgcn_rcpf(pa * pb);
                        sg[4 * n + j] = pa * rp; r[4 * n + j] = pb * pb * rp; }
                u32x4 w; w.x = pkh(r[0], r[1]); w.y = pkh(r[2], r[3]); w.z = pkh(r[4], r[5]); w.w = pkh(r[6], r[7]);
                *(u32x4*)rowp = w;
                w.x = pkh(sg[0], sg[1]); w.y = pkh(sg[2], sg[3]); w.z = pkh(sg[4], sg[5]); w.w = pkh(sg[6], sg[7]);
                *(u32x4*)(rowp + 32768) = w; }
    }
};
struct EpiG2 {
    static constexpr bool MID = true;
    const h16* PG; h16* MG;
    __device__ __forceinline__ void operator()(f32x4 (&acc)[2][2][4][2], const Unit& u, int wr, int wc, int fr, int fq) const {
        const int row0 = u.pm * BM + wr * 64 + fr, col0 = u.pn * BM + wc * 32 + 8 * fq;
        const h16* gbase = PG + (size_t)(u.pm * 32 + 2 * u.pn) * 65536 + (u.half == 0 ? 0 : 32768) + (wr * 4 + wc) * 512 + (fq * 16 + fr) * 8;
#pragma unroll
        for (int ai = 0; ai < 2; ++ai) {
            h16x8 gt[4][2];
#pragma unroll
            for (int m = 0; m < 4; ++m)
#pragma unroll
                for (int bj = 0; bj < 2; ++bj) gt[m][bj] = *(const h16x8*)(gbase + (size_t)bj * 65536 + (ai * 4 + m) * 4096);
            if (u.half == 0) {
#pragma unroll
                for (int m = 0; m < 4; ++m)
#pragma unroll
                    for (int bj = 0; bj < 2; ++bj)
#pragma unroll
                        for (int j = 0; j < 4; ++j) { acc[ai][bj][m][0][j] *= (float)gt[m][bj][j]; acc[ai][bj][m][1][j] *= (float)gt[m][bj][4 + j]; }
            } else {
#pragma unroll
                for (int m = 0; m < 4; ++m) { const size_t row = (size_t)(row0 + ai * HALF + m * 16);
#pragma unroll
                    for (int bj = 0; bj < 2; ++bj) { const int col = col0 + bj * HALF;
                        float o[8];
#pragma unroll
                        for (int j = 0; j < 4; ++j) { o[j] = acc[ai][bj][m][0][j] * (float)gt[m][bj][j]; o[4 + j] = acc[ai][bj][m][1][j] * (float)gt[m][bj][4 + j]; }
                        u32x4 w; w.x = pkg(o[0], o[1]); w.y = pkg(o[2], o[3]); w.z = pkg(o[4], o[5]); w.w = pkg(o[6], o[7]);
                        *(u32x4*)(MG + row * D + col) = w; } }
            }
            __builtin_amdgcn_sched_barrier(0);
        }
    }
};
struct EpiG3 {
    static constexpr bool MID = false;
    const float* x; h16* HB; float* ssq; unsigned* cnt;
    __device__ __forceinline__ void operator()(const f32x4 (&acc)[2][2][4][2], const Unit& u, int wr, int wc, int fr, int fq) const {
        const int row0 = u.pm * BM + wr * 64 + fr, col0 = u.pn * BM + wc * 32 + 8 * fq;
#pragma unroll
        for (int ai = 0; ai < 2; ++ai) {
            f32x4 xv[4][2][2];
#pragma unroll
            for (int m = 0; m < 4; ++m)
#pragma unroll
                for (int bj = 0; bj < 2; ++bj) { const float* xp = x + (size_t)(row0 + ai * HALF + m * 16) * D + col0 + bj * HALF; xv[m][bj][0] = *(const f32x4*)xp; xv[m][bj][1] = *(const f32x4*)(xp + 4); }
#pragma unroll
            for (int m = 0; m < 4; ++m) { const size_t row = (size_t)(row0 + ai * HALF + m * 16); float s = 0.f;
#pragma unroll
                for (int bj = 0; bj < 2; ++bj) { const size_t o = row * D + col0 + bj * HALF;
                    const f32x4 h0 = xv[m][bj][0] + acc[ai][bj][m][0], h1 = xv[m][bj][1] + acc[ai][bj][m][1];
                    s += (h0[0] * h0[0] + h0[1] * h0[1]) + (h0[2] * h0[2] + h0[3] * h0[3]) + (h1[0] * h1[0] + h1[1] * h1[1]) + (h1[2] * h1[2] + h1[3] * h1[3]);
                    u32x4 w; w.x = pkh(h0[0], h0[1]); w.y = pkh(h0[2], h0[3]); w.z = pkh(h1[0], h1[1]); w.w = pkh(h1[2], h1[3]);
                    *(u32x4*)(HB + o) = w; }
                s += __shfl_xor(s, 16); s += __shfl_xor(s, 32);
                if (fq == 0) (void)__hip_atomic_fetch_add(ssq + row, s, __ATOMIC_RELAXED, __HIP_MEMORY_SCOPE_AGENT); }
        }
        asm volatile("s_waitcnt vmcnt(0)" ::: "memory");
        if (fr == 0 && fq == 0) (void)__hip_atomic_fetch_add(cnt + 64 * u.pm, 1u, __ATOMIC_RELAXED, __HIP_MEMORY_SCOPE_AGENT);
    }
};
__device__ __forceinline__ void final_tile(const Unit& u, const h16* HB, float* ssq, unsigned* cnt, const float* fnw, float* out, int tid) {
    const int lane = tid & 63, wave = tid >> 6;
    if (tid == 0) {
        unsigned sp = 0;
        while (__hip_atomic_load(cnt + 64 * u.pm, __ATOMIC_RELAXED, __HIP_MEMORY_SCOPE_AGENT) < 16u * 8u) { __builtin_amdgcn_s_sleep(1); if (++sp > (1u << 24)) break; }
        __builtin_amdgcn_fence(__ATOMIC_ACQUIRE, "agent");
        asm volatile("s_waitcnt vmcnt(0)" ::: "memory");
    }
    __syncthreads();
    const int c0 = u.pn * BM + 4 * lane;
    const f32x4 w4 = *(const f32x4*)(fnw + c0);
#pragma unroll 1
    for (int rb = wave; rb < BM; rb += 64) {
        h16x4 hv[8]; float sq[8];
#pragma unroll
        for (int q = 0; q < 8; ++q) { const size_t row = (size_t)u.pm * BM + rb + 8 * q; hv[q] = *(const h16x4*)(HB + row * D + c0); sq[q] = __hip_atomic_load(ssq + row, __ATOMIC_RELAXED, __HIP_MEMORY_SCOPE_AGENT); }
#pragma unroll
        for (int q = 0; q < 8; ++q) { const size_t row = (size_t)u.pm * BM + rb + 8 * q; const float rs = rsqrtf(sq[q] * (1.f / D) + EPS);
            f32x4 o; o[0] = (float)hv[q][0] * rs * w4[0]; o[1] = (float)hv[q][1] * rs * w4[1]; o[2] = (float)hv[q][2] * rs * w4[2]; o[3] = (float)hv[q][3] * rs * w4[3];
            *(f32x4*)(out + row * D + c0) = o; }
    }
}
}

__device__ __forceinline__ int w1_col_of(int vr) {
    const int tile = vr >> 8, v = vr & 255;
    if (tile < 64) {
        const int ti = tile >> 1;
        if ((tile & 1) == 0) return 256 * ti + (v & ~31) + pg8::perm32(v & 31);
        const int bj = v >> 7, vv = v & 127, ch = 128 * (ti >> 1) + (vv & ~31) + pg8::perm32(vv & 31);
        const int kind = (ti & 1) ? (bj ? 3 : 0) : (bj ? 2 : 1);
        return 8192 + kind * HW + ch;
    }
    { const int c = tile - 64, bj = v >> 7, vv = v & 127; return 16384 + bj * D + 128 * c + (vv & ~31) + pg8::perm32(vv & 31); }
}
struct TItem { const float* src; h16* dst; int N, ldk; int f8; };
struct Ptrs {
    const float *x, *norm_w, *w_in, *lb_logits, *hgrn_nw, *conv_w, *w_a, *w_b, *gate_bias, *w_out, *final_nw;
    float* out; float* ssq; float* Dn;
    h16 *W1T, *WABT, *WOT, *U, *PA, *PG, *PP, *PGG, *YAB, *L, *MG; unsigned short* S; unsigned char *U8, *W8T; unsigned* cnt;
};

__device__ __forceinline__ TItem t_decode(const Ptrs& P, int it, int lane) {
    constexpr int I_1 = (D / 64) * (NIN / 32), I_A = (HW / 64) * (D / 32), I_O = (D / 64) * (D / 32);
    const int c4 = 4 * (lane & 7), r8 = lane >> 3;
    TItem t; int r = it;
    t.f8 = 0;
    if (r < 2 * I_A + I_O) {
        const int nb = r % (D / 32), vbase = 32 * nb, col = (vbase + c4 & ~31) + pg8::perm32((vbase + c4) & 31);
        if (r < I_A) { const int kb = r / (D / 32); t.N = D; t.ldk = 4096; t.src = P.w_a + (size_t)(64 * kb + r8) * D + col; t.dst = P.WABT + (size_t)vbase * 4096 + 64 * kb; return t; }
        r -= I_A;
        if (r < I_A) { const int kb = r / (D / 32); t.N = D; t.ldk = 4096; t.src = P.w_b + (size_t)(64 * kb + r8) * D + col; t.dst = P.WABT + (size_t)vbase * 4096 + HW + 64 * kb; return t; }
        r -= I_A;
        { const int kb = r / (D / 32); t.N = D; t.ldk = D; t.src = P.w_out + (size_t)(64 * kb + r8) * D + col; t.dst = P.WOT + (size_t)vbase * D + 64 * kb; return t; }
    }
    r -= 2 * I_A + I_O;
    { const int nb = r % (NIN / 32), kb = r / (NIN / 32), vbase = 32 * nb;
        t.N = NIN; t.ldk = D; t.src = P.w_in + (size_t)(64 * kb + r8) * NIN + w1_col_of(vbase + c4);
        if (vbase < 16384) t.dst = P.W1T + (size_t)vbase * D + 64 * kb;
        else { t.f8 = 1; t.dst = (h16*)(P.W8T + (size_t)(vbase - 16384) * D + 64 * kb); }
        return t; }
}
__device__ __forceinline__ void t_load(const TItem& t, f32x4 (&v)[8]) {
#pragma unroll
    for (int j = 0; j < 8; ++j) v[j] = __builtin_nontemporal_load((const f32x4*)(t.src + (size_t)(8 * j) * t.N));
}
__device__ __forceinline__ void p0_prologue(const Ptrs& P, LAS unsigned char* lds, int vcu, int G, int tid) {
    const int lane = tid & 63, wave = __builtin_amdgcn_readfirstlane(tid >> 6);
    LAS float* scr = (LAS float*)(lds + wave * 16384);
    const int gw = vcu * 8 + wave, NGW = G * 8;
    constexpr int NITEMS = (D / 64) * (NIN / 32) + 2 * (HW / 64) * (D / 32) + (D / 64) * (D / 32);
    if (gw < NITEMS) {
        TItem cur = t_decode(P, gw, lane); f32x4 v[8]; t_load(cur, v);
        for (int it = gw; it < NITEMS; it += NGW) {
            const int nit = it + NGW; const bool has_n = nit < NITEMS;
            f32x4 nv[8];
            const TItem nxt = t_decode(P, has_n ? nit : it, lane); t_load(nxt, nv);
            const int c4 = 4 * (lane & 7), r8 = lane >> 3;
#pragma unroll
            for (int j = 0; j < 8; ++j) { LAS float* d = scr + (8 * j + r8) * 33 + c4; d[0] = v[j][0]; d[1] = v[j][1]; d[2] = v[j][2]; d[3] = v[j][3]; }
            asm volatile("s_waitcnt lgkmcnt(0)" ::: "memory");
            const int c = lane & 7;
            if (cur.f8) {
#pragma unroll
                for (int j = 0; j < 4; ++j) { const int n = (lane >> 3) + 8 * j; const LAS float* sp = scr + (8 * c) * 33 + n;
                    int w0 = 0, w1 = 0;
                    w0 = __builtin_amdgcn_cvt_pk_fp8_f32(sp[0 * 33] * F8_SW, sp[1 * 33] * F8_SW, w0, false); w0 = __builtin_amdgcn_cvt_pk_fp8_f32(sp[2 * 33] * F8_SW, sp[3 * 33] * F8_SW, w0, true);
                    w1 = __builtin_amdgcn_cvt_pk_fp8_f32(sp[4 * 33] * F8_SW, sp[5 * 33] * F8_SW, w1, false); w1 = __builtin_amdgcn_cvt_pk_fp8_f32(sp[6 * 33] * F8_SW, sp[7 * 33] * F8_SW, w1, true);
                    u32x2 o; o.x = (unsigned)w0; o.y = (unsigned)w1;
                    *(u32x2*)((unsigned char*)cur.dst + (size_t)n * cur.ldk + 8 * c) = o; }
            } else {
#pragma unroll
                for (int j = 0; j < 4; ++j) { const int n = (lane >> 3) + 8 * j; const LAS float* sp = scr + (8 * c) * 33 + n;
                    u32x4 o; o.x = pkg(sp[0 * 33], sp[1 * 33]); o.y = pkg(sp[2 * 33], sp[3 * 33]); o.z = pkg(sp[4 * 33], sp[5 * 33]); o.w = pkg(sp[6 * 33], sp[7 * 33]);
                    *(u32x4*)(cur.dst + (size_t)n * cur.ldk + 8 * c) = o; }
            }
            asm volatile("s_waitcnt lgkmcnt(0)" ::: "memory");
#pragma unroll
            for (int j = 0; j < 8; ++j) v[j] = nv[j];
            cur = nxt;
        }
    }
    {
        f32x4 nwv[16];
#pragma unroll
        for (int j = 0; j < 16; ++j) nwv[j] = *((const f32x4*)P.norm_w + lane + 64 * j);
#pragma nounroll
        for (int m = gw; m < T; m += NGW) {
            const f32x4* xr = (const f32x4*)(P.x + (size_t)m * D) + lane;
            f32x4 v[16]; float s = 0.f;
#pragma unroll
            for (int j = 0; j < 16; ++j) v[j] = __builtin_nontemporal_load(xr + 64 * j);
#pragma unroll
            for (int j = 0; j < 16; ++j) s += (v[j][0] * v[j][0] + v[j][1] * v[j][1]) + (v[j][2] * v[j][2] + v[j][3] * v[j][3]);
            const float rs = rsqrtf(wave_sum(s) * (1.f / D) + EPS), s8 = rs * F8_SU;
            u32x2* o = (u32x2*)(P.U + (size_t)m * D) + lane;
            unsigned* o8 = (unsigned*)(P.U8 + (size_t)m * D) + lane;
#pragma unroll
            for (int j = 0; j < 16; ++j) { const f32x4 w = nwv[j]; const float a0 = v[j][0] * w[0], a1 = v[j][1] * w[1], a2 = v[j][2] * w[2], a3 = v[j][3] * w[3];
                u32x2 q; q.x = pkg(a0 * rs, a1 * rs); q.y = pkg(a2 * rs, a3 * rs); o[64 * j] = q;
                int w8 = 0; w8 = __builtin_amdgcn_cvt_pk_fp8_f32(a0 * s8, a1 * s8, w8, false); w8 = __builtin_amdgcn_cvt_pk_fp8_f32(a2 * s8, a3 * s8, w8, true); o8[64 * j] = (unsigned)w8; }
        }
    }
    for (int i = blockIdx.x * 512 + tid; i < T; i += G * 512) P.ssq[i] = 0.f;
}

__device__ __forceinline__ bf16x8 mk_bf16x8(const float (&v)[8]) {
    u32x4 w; w.x = f2bf(v[0]) | (f2bf(v[1]) << 16); w.y = f2bf(v[2]) | (f2bf(v[3]) << 16); w.z = f2bf(v[4]) | (f2bf(v[5]) << 16); w.w = f2bf(v[6]) | (f2bf(v[7]) << 16);
    return __builtin_bit_cast(bf16x8, w);
}
__device__ __forceinline__ void load_vt(const h16* vsrc, LAS unsigned short* VT, int tid) {
#pragma unroll
    for (int rep = 0; rep < 2; ++rep) { const int cidx = tid + 512 * rep, s = cidx >> 4, ec = (cidx & 15) * 8;
        const h16x8 v = *(const h16x8*)(vsrc + (size_t)s * 8192 + ec);
#pragma unroll
        for (int x = 0; x < 8; ++x) VT[(ec + x) * 72 + s] = (unsigned short)f2bf((float)v[x]); }
}

__device__ __forceinline__ void h1_item(const Ptrs& P, LAS unsigned char* lds, int n, int h, int tid) {
    LAS unsigned short* KT = (LAS unsigned short*)lds;
    LAS unsigned short* VT = KT + 128 * 72;
    LAS float* tot = (LAS float*)(VT + 128 * 72);
    const int d = tid & 127, i = tid >> 7, lane = tid & 63, w = tid >> 6, t0 = n * CH;
    const h16* fp = P.PA + (size_t)(t0 + 16 * i) * 8192 + HW + h * HD + d;
    const float l0 = P.lb_logits[h * HD + d], l1 = P.lb_logits[HW + h * HD + d];
    const float oml = 1.f - __builtin_amdgcn_rcpf(1.f + __expf(l1 - l0));
    float kk[16], c[16], run = 0.f;
#pragma unroll
    for (int u = 0; u < 16; ++u) { const float xv = (float)fp[(size_t)u * 8192]; const float k = oml * __builtin_amdgcn_rcpf(1.f + __expf(xv)); run += __logf(1.f - k); kk[u] = k; c[u] = run; }
    tot[i * 128 + d] = run;
    load_vt(P.PA + (size_t)t0 * 8192 + 2 * HW + h * HD, VT, tid);
    __syncthreads();
    float R = 0.f;
#pragma unroll
    for (int j = 1; j < 4; ++j) if (j > i) R += tot[j * 128 + d];
    const float base = R + run;
    float v0[8], v1[8];
#pragma unroll
    for (int u = 0; u < 8; ++u) { v0[u] = kk[u] * __expf(base - c[u]); v1[u] = kk[8 + u] * __expf(base - c[8 + u]); }
    *(LAS bf16x8*)(KT + d * 72 + 16 * i) = mk_bf16x8(v0);
    *(LAS bf16x8*)(KT + d * 72 + 16 * i + 8) = mk_bf16x8(v1);
    if (i == 0) P.Dn[(size_t)(n * NH + h) * HD + d] = __expf(base);
    __syncthreads();
    f32x4 acc[8];
#pragma unroll
    for (int nn = 0; nn < 8; ++nn) acc[nn] = (f32x4){0.f, 0.f, 0.f, 0.f};
#pragma unroll
    for (int k2 = 0; k2 < 2; ++k2) {
        const bf16x8 a = *(const LAS bf16x8*)(VT + (16 * w + (lane & 15)) * 72 + 32 * k2 + 8 * (lane >> 4));
#pragma unroll
        for (int nn = 0; nn < 8; ++nn) { const bf16x8 b = *(const LAS bf16x8*)(KT + (16 * nn + (lane & 15)) * 72 + 32 * k2 + 8 * (lane >> 4));
            acc[nn] = __builtin_amdgcn_mfma_f32_16x16x32_bf16(a, b, acc[nn], 0, 0, 0); }
    }
    h16* Lp = P.L + (size_t)(n * NH + h) * (HD * HD);
#pragma unroll
    for (int nn = 0; nn < 8; ++nn)
#pragma unroll
        for (int j = 0; j < 4; ++j) Lp[(16 * w + 4 * (lane >> 4) + j) * HD + 16 * nn + (lane & 15)] = (h16)acc[nn][j];
    __syncthreads();
}

__device__ __forceinline__ void yb_phase(const Ptrs& P, int G, int tid) {
    for (int it = blockIdx.x * 512 + tid; it < (T / 8) * (HW / 8); it += G * 512) {
        const int c = (it & 255) * 8, t0 = (it >> 8) * 8;
        float w0[8], w1[8], w2[8], pm2[8], pm1[8];
#pragma unroll
        for (int q = 0; q < 2; ++q) { const f32x4 a = *(const f32x4*)(P.conv_w + c + 4 * q), b = *(const f32x4*)(P.conv_w + HW + c + 4 * q), cc = *(const f32x4*)(P.conv_w + 2 * HW + c + 4 * q);
#pragma unroll
            for (int j = 0; j < 4; ++j) { w0[4 * q + j] = a[j]; w1[4 * q + j] = b[j]; w2[4 * q + j] = cc[j]; } }
        if (t0 > 0) { const h16x8 a = *(const h16x8*)(P.PP + (size_t)(t0 - 2) * HW + c), b = *(const h16x8*)(P.PP + (size_t)(t0 - 1) * HW + c);
#pragma unroll
            for (int j = 0; j < 8; ++j) { pm2[j] = (float)a[j]; pm1[j] = (float)b[j]; } }
        else {
#pragma unroll
            for (int j = 0; j < 8; ++j) { pm2[j] = 0.f; pm1[j] = 0.f; } }
        h16x8 pcv[8], ggv[8];
#pragma unroll
        for (int r = 0; r < 8; ++r) { pcv[r] = *(const h16x8*)(P.PP + (size_t)(t0 + r) * HW + c); ggv[r] = *(const h16x8*)(P.PGG + (size_t)(t0 + r) * HW + c); }
#pragma unroll
        for (int r = 0; r < 8; ++r) {
            const h16x8 pc = pcv[r], gg = ggv[r];
            float y[8];
#pragma unroll
            for (int j = 0; j < 8; ++j) { const float pcf = (float)pc[j]; y[j] = (float)gg[j] * (w0[j] * pm2[j] + w1[j] * pm1[j] + w2[j] * pcf); pm2[j] = pm1[j]; pm1[j] = pcf; }
            u32x4 o; o.x = pkg(y[0], y[1]); o.y = pkg(y[2], y[3]); o.z = pkg(y[4], y[5]); o.w = pkg(y[6], y[7]);
            *(u32x4*)(P.YAB + (size_t)(t0 + r) * D + HW + c) = o;
        }
    }
}

__device__ __forceinline__ void h2_phase(const Ptrs& P, int G, int tid) {
    constexpr size_t SLAB = (size_t)NH * HD * HD;
    constexpr int UB = 16;
    for (int idx = blockIdx.x * 512 + tid; idx < NH * HD * (HD / 2); idx += G * 512) {
        const int d2 = idx & 63, e = (idx >> 6) & 127, h = idx >> 13;
        const size_t off = ((size_t)h * HD + e) * HD + 2 * d2;
        float s0 = 0.f, s1 = 0.f;
        for (int nb = 0; nb < NCH; nb += UB) {
            h16x2 l[UB]; f32x2 dd[UB];
#pragma unroll
            for (int q = 0; q < UB; ++q) { l[q] = *(const h16x2*)(P.L + (size_t)(nb + q) * SLAB + off); dd[q] = *(const f32x2*)(P.Dn + (size_t)((nb + q) * NH + h) * HD + 2 * d2); }
#pragma unroll
            for (int q = 0; q < UB; ++q) {
                *(unsigned*)(P.S + (size_t)(nb + q) * SLAB + off) = f2bf(s0) | (f2bf(s1) << 16);
                s0 = dd[q][0] * s0 + (float)l[q][0]; s1 = dd[q][1] * s1 + (float)l[q][1]; }
        }
    }
}

__device__ __forceinline__ unsigned short bf1(float x) { unsigned r; asm("v_cvt_pk_bf16_f32 %0, %1, %1" : "=v"(r) : "v"(x)); return (unsigned short)r; }
__device__ __forceinline__ int vt_idx(int e, int s) { return e * 72 + (s ^ (((e >> 3) & 7) << 3)); }
__device__ __forceinline__ void tile_ld(const h16* src, h16x8 (&r)[2], int tid) {
#pragma unroll
    for (int rep = 0; rep < 2; ++rep) { const int cidx = tid + 512 * rep; r[rep] = *(const h16x8*)(src + (size_t)(cidx >> 4) * 8192 + (cidx & 15) * 8); }
}
__device__ __forceinline__ void tile_st(LAS h16* dst, const h16x8 (&r)[2], int tid) {
#pragma unroll
    for (int rep = 0; rep < 2; ++rep) { const int cidx = tid + 512 * rep; *(LAS h16x8*)(dst + (cidx >> 4) * 128 + (cidx & 15) * 8) = r[rep]; }
}
__device__ __forceinline__ void vt_st(LAS unsigned short* VT, const h16x8 (&r)[2], int tid) {
#pragma unroll
    for (int rep = 0; rep < 2; ++rep) { const int cidx = tid + 512 * rep, sI = cidx >> 4, ec = (cidx & 15) * 8;
#pragma unroll
        for (int x = 0; x < 8; ++x) VT[vt_idx(ec + x, sI)] = bf1((float)r[rep][x]); }
}

__device__ __forceinline__ float row16_sum(float v) {
    v += __builtin_bit_cast(float, __builtin_amdgcn_mov_dpp(__builtin_bit_cast(int, v), 0xB1, 0xF, 0xF, true));
    v += __builtin_bit_cast(float, __builtin_amdgcn_mov_dpp(__builtin_bit_cast(int, v), 0x4E, 0xF, 0xF, true));
    v += __builtin_bit_cast(float, __builtin_amdgcn_mov_dpp(__builtin_bit_cast(int, v), 0x141, 0xF, 0xF, true));
    v += __builtin_bit_cast(float, __builtin_amdgcn_mov_dpp(__builtin_bit_cast(int, v), 0x140, 0xF, 0xF, true));
    return v;
}
__device__ __forceinline__ void h1_phase(const Ptrs& P, LAS unsigned char* lds, int bx, int G, int tid) {
    LAS unsigned short* KT = (LAS unsigned short*)lds;
    LAS unsigned short* VT = KT + 128 * 72;
    LAS float* tot = (LAS float*)(VT + 128 * 72);
    LAS h16* FST = (LAS h16*)(tot + 512);
    LAS h16* LT = FST + 64 * 128;
    const int d = tid & 127, i = __builtin_amdgcn_readfirstlane(tid >> 7), lane = tid & 63, w = __builtin_amdgcn_readfirstlane(tid >> 6);
    const int fr = lane & 15, fq = lane >> 4;
    const int NIT = NCH * NH;
    if (bx >= NIT) return;
    h16x8 pf[2], pv[2];
#define H1_PREFETCH(itn) do { const int n_ = (itn) >> 4, h_ = (itn) & 15; const h16* base_ = P.PA + (size_t)(n_ * CH) * 8192 + h_ * HD; \
        tile_ld(base_ + HW, pf, tid); tile_ld(base_ + 2 * HW, pv, tid); } while (0)
#define H1_FLUSH(itp) do { h16* Lp_ = P.L + (size_t)(itp) * (HD * HD); \
        _Pragma("unroll") for (int rep = 0; rep < 4; ++rep) { const int cidx = tid + 512 * rep; *(h16x8*)(Lp_ + cidx * 8) = *(const LAS h16x8*)(LT + cidx * 8); } } while (0)
    H1_PREFETCH(bx);
    const bool hfix = (G & 15) == 0;
    float l0 = P.lb_logits[(bx & 15) * HD + d], l1 = P.lb_logits[HW + (bx & 15) * HD + d];
    int itprev = -1;
    for (int it = bx; it < NIT; it += G) {
        const int n = it >> 4, h = it & 15;
        if (!hfix) { l0 = P.lb_logits[h * HD + d]; l1 = P.lb_logits[HW + h * HD + d]; }
        tile_st(FST, pf, tid); vt_st(VT, pv, tid);
        __syncthreads();
        const float oml = 1.f - __builtin_amdgcn_rcpf(1.f + __expf(l1 - l0));
        float kk[16], pc[16], run = 1.f;
#pragma unroll
        for (int u = 0; u < 16; ++u) { const float xv = (float)FST[(16 * i + u) * 128 + d]; const float k = oml * __builtin_amdgcn_rcpf(1.f + __expf(xv)); run *= (1.f - k); kk[u] = k; pc[u] = run; }
        tot[i * 128 + d] = run;
        __syncthreads();
        float base = run;
#pragma unroll
        for (int j = 1; j < 4; ++j) if (j > i) base *= tot[j * 128 + d];
        float v0[8], v1[8];
#pragma unroll
        for (int u = 0; u < 8; ++u) { v0[u] = kk[u] * base * __builtin_amdgcn_rcpf(pc[u]); v1[u] = kk[8 + u] * base * __builtin_amdgcn_rcpf(pc[8 + u]); }
        *(LAS bf16x8*)(KT + d * 72 + 16 * i) = mk_bf16x8(v0);
        *(LAS bf16x8*)(KT + d * 72 + 16 * i + 8) = mk_bf16x8(v1);
        if (i == 0) P.Dn[(size_t)it * HD + d] = base;
        if (itprev >= 0) H1_FLUSH(itprev);
        { const int nit = it + G; H1_PREFETCH(nit < NIT ? nit : it); }
        __syncthreads();
        f32x4 acc[8];
#pragma unroll
        for (int nn = 0; nn < 8; ++nn) acc[nn] = (f32x4){0.f, 0.f, 0.f, 0.f};
#pragma unroll
        for (int k2 = 0; k2 < 2; ++k2) {
            const bf16x8 a = *(const LAS bf16x8*)(VT + vt_idx(16 * w + fr, 32 * k2 + 8 * fq));
#pragma unroll
            for (int nn = 0; nn < 8; ++nn) { const bf16x8 b = *(const LAS bf16x8*)(KT + (16 * nn + fr) * 72 + 32 * k2 + 8 * fq);
                acc[nn] = __builtin_amdgcn_mfma_f32_16x16x32_bf16(a, b, acc[nn], 0, 0, 0); }
        }
#pragma unroll
        for (int nn = 0; nn < 8; ++nn)
#pragma unroll
            for (int j = 0; j < 4; ++j) LT[(16 * w + 4 * fq + j) * HD + 16 * nn + fr] = (h16)acc[nn][j];
        itprev = it;
        __syncthreads();
    }
    if (itprev >= 0) H1_FLUSH(itprev);
#undef H1_PREFETCH
#undef H1_FLUSH
}

__device__ __forceinline__ void h3_phase(const Ptrs& P, LAS unsigned char* lds, int bx, int G, int tid) {
    constexpr int QS = 136;
    LAS unsigned short* Q1 = (LAS unsigned short*)lds;
    LAS unsigned short* Q2 = Q1 + 64 * QS;
    LAS unsigned short* KH = Q2 + 64 * QS;
    LAS h16* FST = (LAS h16*)KH;
    LAS h16* QST = FST + 64 * 128;
    LAS unsigned short* Pm = KH + 160 * QS;
    LAS unsigned short* VT = Pm + 64 * 72;
    LAS float* tot = (LAS float*)(VT + 128 * 72);
    LAS float* red = tot + 512;
    LAS h16* GST = (LAS h16*)(red + 512);
    LAS unsigned short* YST = (LAS unsigned short*)(GST + 64 * 128);
    const int d = tid & 127, i = __builtin_amdgcn_readfirstlane(tid >> 7), lane = tid & 63, w = __builtin_amdgcn_readfirstlane(tid >> 6);
    const int fr = lane & 15, fq = lane >> 4;
    const int NIT = NCH * NH;
    if (bx >= NIT) return;
    h16x8 pf[2], pq[2], pv[2], pg[2]; bf16x8 psb[4];
#define H3_PREFETCH(itn) do { const int n_ = (itn) >> 4, h_ = (itn) & 15; const h16* base_ = P.PA + (size_t)(n_ * CH) * 8192 + h_ * HD; \
        tile_ld(base_, pq, tid); tile_ld(base_ + HW, pf, tid); tile_ld(base_ + 2 * HW, pv, tid); tile_ld(base_ + 3 * HW, pg, tid); \
        const unsigned short* Sp_ = P.S + (size_t)(n_ * NH + h_) * (HD * HD) + (16 * w + fr) * HD + 8 * fq; \
        _Pragma("unroll") for (int k2 = 0; k2 < 4; ++k2) psb[k2] = *(const bf16x8*)(Sp_ + 32 * k2); } while (0)
    H3_PREFETCH(bx);
    const bool hfix = (G & 15) == 0;
    float l0 = P.lb_logits[(bx & 15) * HD + d], l1 = P.lb_logits[HW + (bx & 15) * HD + d], nwv = P.hgrn_nw[16 * w + fr];
    size_t yoff = 0; bool have_y = false;
#define H3_FLUSH() do { _Pragma("unroll") for (int rep = 0; rep < 2; ++rep) { const int cidx = tid + 512 * rep; \
        *(u32x4*)((unsigned short*)P.YAB + yoff + (size_t)(cidx >> 4) * D + (cidx & 15) * 8) = *(const LAS u32x4*)(YST + (cidx >> 4) * 128 + (cidx & 15) * 8); } } while (0)
    for (int it = bx; it < NIT; it += G) {
        const int n = it >> 4, h = it & 15, t0 = n * CH;
        if (!hfix) { l0 = P.lb_logits[h * HD + d]; l1 = P.lb_logits[HW + h * HD + d]; }
        tile_st(FST, pf, tid); tile_st(QST, pq, tid); vt_st(VT, pv, tid);
        bf16x8 sb[4];
#pragma unroll
        for (int k2 = 0; k2 < 4; ++k2) sb[k2] = psb[k2];
        __syncthreads();
        const float oml = 1.f - __builtin_amdgcn_rcpf(1.f + __expf(l1 - l0));
        float kk[16], pc[16], qq[16], run = 1.f;
#pragma unroll
        for (int u = 0; u < 16; ++u) { const float xv = (float)FST[(16 * i + u) * 128 + d]; qq[u] = (float)QST[(16 * i + u) * 128 + d];
            const float k = oml * __builtin_amdgcn_rcpf(1.f + __expf(xv)); run *= (1.f - k); kk[u] = k; pc[u] = run; }
        tot[i * 128 + d] = run;
        for (int z = tid; z < 64 * 72 / 8; z += 512) ((LAS u32x4*)Pm)[z] = (u32x4){0u, 0u, 0u, 0u};
        if (tid < 64) red[tid] = 0.f;
        __syncthreads();
        tile_st(GST, pg, tid);
        {
            float tt[4];
#pragma unroll
            for (int j = 0; j < 4; ++j) tt[j] = tot[j * 128 + d];
            float er = 1.f;
#pragma unroll
            for (int j = 0; j < 4; ++j) if (j < i) er *= tt[j];
            float erho[4];
#pragma unroll
            for (int ip = 0; ip < 4; ++ip) { float rho = 1.f;
#pragma unroll
                for (int j = 0; j < 4; ++j) if (j >= i && j < ip) rho *= tt[j];
                erho[ip] = rho; }
            float kd[16];
#pragma unroll
            for (int u = 0; u < 16; ++u) { const int t = 16 * i + u;
                const float q2 = qq[u] * pc[u]; kd[u] = kk[u] * __builtin_amdgcn_rcpf(pc[u]);
                Q2[t * QS + d] = bf1(q2);
                Q1[t * QS + d] = bf1(q2 * er); }
#pragma unroll
            for (int ip = 0; ip < 4; ++ip) {
                if (ip >= i) {
                    const int rb = 8 * ip * (ip + 1) + 16 * i;
#pragma unroll
                    for (int u = 0; u < 16; ++u) KH[(rb + u) * QS + d] = bf1(kd[u] * erho[ip]);
                }
            }
        }
        if (have_y) H3_FLUSH();
        { const int nit = it + G; H3_PREFETCH(nit < NIT ? nit : it); }
        __syncthreads();
        for (int idx = w; idx < 10; idx += 8) {
            const int i2 = idx >= 6 ? 3 : (idx >= 3 ? 2 : (idx >= 1 ? 1 : 0)), j2 = idx - (i2 * (i2 + 1)) / 2;
            f32x4 sc = (f32x4){0.f, 0.f, 0.f, 0.f};
#pragma unroll
            for (int k2 = 0; k2 < 4; ++k2) {
                const bf16x8 a = *(const LAS bf16x8*)(Q2 + (16 * i2 + fr) * QS + 32 * k2 + 8 * fq);
                const bf16x8 b = *(const LAS bf16x8*)(KH + (8 * i2 * (i2 + 1) + 16 * j2 + fr) * QS + 32 * k2 + 8 * fq);
                sc = __builtin_amdgcn_mfma_f32_16x16x32_bf16(a, b, sc, 0, 0, 0);
            }
#pragma unroll
            for (int jj = 0; jj < 4; ++jj) { const int tl = 4 * fq + jj; const float v = (i2 == j2 && fr > tl) ? 0.f : sc[jj];
                Pm[(16 * i2 + tl) * 72 + 16 * j2 + fr] = bf1(v); }
        }
        __syncthreads();
        f32x4 o[4];
#pragma unroll
        for (int m = 0; m < 4; ++m) o[m] = (f32x4){0.f, 0.f, 0.f, 0.f};
#pragma unroll
        for (int k2 = 0; k2 < 4; ++k2)
#pragma unroll
            for (int m = 0; m < 4; ++m) { const bf16x8 a = *(const LAS bf16x8*)(Q1 + (16 * m + fr) * QS + 32 * k2 + 8 * fq);
                o[m] = __builtin_amdgcn_mfma_f32_16x16x32_bf16(a, sb[k2], o[m], 0, 0, 0); }
#pragma unroll
        for (int k2 = 0; k2 < 2; ++k2) { const bf16x8 b = *(const LAS bf16x8*)(VT + vt_idx(16 * w + fr, 32 * k2 + 8 * fq));
#pragma unroll
            for (int m = 0; m < 4; ++m) { if (k2 == 1 && m < 2) continue;
                const bf16x8 a = *(const LAS bf16x8*)(Pm + (16 * m + fr) * 72 + 32 * k2 + 8 * fq);
                o[m] = __builtin_amdgcn_mfma_f32_16x16x32_bf16(a, b, o[m], 0, 0, 0); } }
#pragma unroll
        for (int m = 0; m < 4; ++m)
#pragma unroll
            for (int jj = 0; jj < 4; ++jj) { const float sq = row16_sum(o[m][jj] * o[m][jj]);
                if (fr == 0) __builtin_amdgcn_ds_faddf(red + 16 * m + 4 * fq + jj, sq, 0, 0, false); }
        __syncthreads();
        const int e = 16 * w + fr;
#pragma unroll
        for (int m = 0; m < 4; ++m)
#pragma unroll
            for (int jj = 0; jj < 4; ++jj) { const int t = 16 * m + 4 * fq + jj; const float ss = red[t];
                const float rs = rsqrtf(ss * (1.f / HD) + EPS);
                const float gv = (float)GST[t * 128 + e];
                const float yv = o[m][jj] * rs * nwv * gv * sigmoidf_(gv);
#if GEMM_BF16
                YST[t * 128 + e] = bf1(yv);
#else
                YST[t * 128 + e] = __builtin_bit_cast(unsigned short, (h16)yv);
#endif
            }
        yoff = (size_t)t0 * D + h * HD; have_y = true;
    }
    __syncthreads();
    if (have_y) H3_FLUSH();
#undef H3_FLUSH
#undef H3_PREFETCH
}

__device__ __forceinline__ void final_phase(const Ptrs& P, int G, int tid) {
    const int lane = tid & 63, wave = tid >> 6;
    f32x4 fw[8][2];
#pragma unroll
    for (int j = 0; j < 8; ++j) { fw[j][0] = *(const f32x4*)(P.final_nw + 8 * (lane + 64 * j)); fw[j][1] = *(const f32x4*)(P.final_nw + 8 * (lane + 64 * j) + 4); }
    for (int row = blockIdx.x * 8 + wave; row < T; row += G * 8) {
        const float rs = rsqrtf(P.ssq[row] * (1.f / D) + EPS);
        const h16x8* hp = (const h16x8*)(P.U + (size_t)row * D) + lane;
        h16x8 hv[8];
#pragma unroll
        for (int j = 0; j < 8; ++j) hv[j] = hp[64 * j];
        f32x4* o = (f32x4*)(P.out + (size_t)row * D) + 2 * lane;
#pragma unroll
        for (int j = 0; j < 8; ++j) {
            f32x4 a0, a1;
#pragma unroll
            for (int q = 0; q < 4; ++q) { a0[q] = (float)hv[j][q] * rs * fw[j][0][q]; a1[q] = (float)hv[j][4 + q] * rs * fw[j][1][q]; }
            o[128 * j] = a0; o[128 * j + 1] = a1; }
    }
}

__device__ __forceinline__ unsigned long long ldptr(LAS const unsigned long long* pt, int k) {
    const unsigned long long v = pt[k]; const unsigned lo = __builtin_amdgcn_readfirstlane((unsigned)v), hi = __builtin_amdgcn_readfirstlane((unsigned)(v >> 32));
    return ((unsigned long long)hi << 32) | lo;
}
#define GAS __attribute__((address_space(1)))
#define GP(T, v) ((T*)(GAS T*)(v))
__device__ __forceinline__ Ptrs mkptrs(LAS const unsigned long long* pt) {
    Ptrs P;
    P.x = GP(const float, ldptr(pt, 0)); P.norm_w = GP(const float, ldptr(pt, 1)); P.w_in = GP(const float, ldptr(pt, 2)); P.lb_logits = GP(const float, ldptr(pt, 3)); P.hgrn_nw = GP(const float, ldptr(pt, 4));
    P.conv_w = GP(const float, ldptr(pt, 5)); P.w_a = GP(const float, ldptr(pt, 6)); P.w_b = GP(const float, ldptr(pt, 7)); P.gate_bias = GP(const float, ldptr(pt, 8)); P.w_out = GP(const float, ldptr(pt, 9));
    P.final_nw = GP(const float, ldptr(pt, 10)); P.out = GP(float, ldptr(pt, 11));
    const unsigned long long ws = ldptr(pt, 12);
    P.ssq = GP(float, ws + WS_SSQ); P.Dn = GP(float, ws + WS_DN);
    P.W1T = GP(h16, ws + WS_W1T); P.WABT = GP(h16, ws + WS_WABT); P.WOT = GP(h16, ws + WS_WOT); P.U = GP(h16, ws + WS_U);
    P.PA = GP(h16, ws + WS_PA); P.PG = GP(h16, ws + WS_PG); P.PP = GP(h16, ws + WS_PP); P.PGG = GP(h16, ws + WS_PGG);
    P.YAB = GP(h16, ws + WS_YAB); P.L = GP(h16, ws + WS_L); P.S = GP(unsigned short, ws + WS_S); P.MG = GP(h16, ws + WS_MG); P.U8 = GP(unsigned char, ws + WS_U8); P.W8T = GP(unsigned char, ws + WS_W8T); P.cnt = GP(unsigned, ws + WS_CNT);
    return P;
}


#define XB_TMO      128
#define XB_XCNT(j)  (256  + 64 * (j))
#define XB_XSUB(j)  (1280 + 64 * (j))
#define XB_XGEN(j)  (2304 + 64 * (j))
#define XB_TOP      3328
#define XB_TOPGEN   3392
#define XCD_BAR_WORDS 3456
#define XB_SPIN_CAP (1u << 22)
__device__ __forceinline__ unsigned xb_ld(unsigned* p)              { return __hip_atomic_load(p, __ATOMIC_RELAXED, __HIP_MEMORY_SCOPE_AGENT); }
__device__ __forceinline__ unsigned xb_add(unsigned* p, unsigned v) { return __hip_atomic_fetch_add(p, v, __ATOMIC_RELAXED, __HIP_MEMORY_SCOPE_AGENT); }
__device__ __forceinline__ unsigned xb_xcc_id() { return (unsigned)__builtin_amdgcn_s_getreg((3 << 11) | 20) & 0xFu; }
#define XB_SPIN(cond, bar) do { unsigned _sp = 0; while (cond) { __builtin_amdgcn_s_sleep(1); \
    if ((++_sp & 255u) == 0u) { if (xb_ld(&(bar)[XB_TMO])) break; if (_sp > XB_SPIN_CAP) { atomicAdd(&(bar)[XB_TMO], 1u); break; } } } } while (0)
__device__ __forceinline__ void xcd_barrier_complete(unsigned* bar, unsigned x, unsigned& nloc, unsigned& nx) {
    const unsigned G = gridDim.x;
    unsigned sum, cnt, mine, sp = 0u;
    for (;;) {
        sum = 0u; cnt = 0u; mine = 0u;
#pragma unroll
        for (unsigned j = 0; j < 16; ++j) { const unsigned c = xb_ld(&bar[XB_XCNT(j)]); sum += c; cnt += (c > 0u) ? 1u : 0u; mine = (j == x) ? c : mine; }
        if (sum == G) break;
        __builtin_amdgcn_s_sleep(1);
        if ((++sp & 255u) == 0u) { if (xb_ld(&bar[XB_TMO])) break; if (sp > XB_SPIN_CAP) { atomicAdd(&bar[XB_TMO], 1u); break; } }
    }
    nloc = mine > 0u ? mine : 1u; nx = cnt > 0u ? cnt : 1u;
}
__device__ __forceinline__ void xcd_barrier(unsigned* bar, volatile LAS unsigned* st, bool is_t0) {
    asm volatile("s_waitcnt vmcnt(0)" ::: "memory");
    __syncthreads();
    if (is_t0) {
        __builtin_amdgcn_s_waitcnt(0);
        const unsigned x = xb_xcc_id();
        unsigned nloc = st[0], nx = st[1];
        if (nloc == 0u) { xcd_barrier_complete(bar, x, nloc, nx); st[0] = nloc; st[1] = nx; }
        const unsigned old = xb_add(&bar[XB_XSUB(x)], 1u);
        const unsigned gen = old / nloc;
        if (old + 1u == (gen + 1u) * nloc) {
            __builtin_amdgcn_fence(__ATOMIC_RELEASE, "agent");
            asm volatile("s_waitcnt vmcnt(0)" ::: "memory");
            const unsigned og = xb_add(&bar[XB_TOP], 1u);
            const unsigned tg = og / nx;
            if (og + 1u == (tg + 1u) * nx) xb_add(&bar[XB_TOPGEN], 1u);
            else XB_SPIN(xb_ld(&bar[XB_TOPGEN]) == tg, bar);
            __builtin_amdgcn_fence(__ATOMIC_ACQUIRE, "agent");
            xb_add(&bar[XB_XGEN(x)], 1u);
            asm volatile("s_waitcnt vmcnt(0)" ::: "memory");
        } else {
            XB_SPIN(xb_ld(&bar[XB_XGEN(x)]) == gen, bar);
            __builtin_amdgcn_fence(__ATOMIC_ACQUIRE, "agent");
            asm volatile("s_waitcnt vmcnt(0)" ::: "memory");
        }
    }
    __syncthreads();
}

struct Args { const float* in[11]; float* out; unsigned char* ws; int ph_lo, ph_hi; };
constexpr int NPH = 8;

template <int COOP>
__global__ void __launch_bounds__(512, 2) mega(Args a) {
    extern __shared__ __attribute__((aligned(16))) unsigned char lds_raw[];
    LAS unsigned char* lds = (LAS unsigned char*)lds_raw;
    const int G = gridDim.x, bx = blockIdx.x, wave0 = __builtin_amdgcn_readfirstlane((int)threadIdx.x >> 6);
    const int vcu = (G % 8 == 0) ? (bx % 8) * (G / 8) + bx / 8 : bx;
    LAS unsigned long long* ptab = (LAS unsigned long long*)(lds + LDS_CTL);
    { const int t0_ = fresh_tid(); if (t0_ < 13) ptab[t0_] = (t0_ < 11) ? (unsigned long long)a.in[t0_] : (t0_ == 11 ? (unsigned long long)a.out : (unsigned long long)a.ws); }
    volatile LAS unsigned* xst = (volatile LAS unsigned*)(lds + LDS_CTL + 128);
    unsigned* xbar = nullptr;
    if constexpr (COOP) {
        xbar = GP(unsigned, (unsigned long long)a.ws + WS_BAR);
        if (lane_id_fresh() == 0 && wave0 == 0) { xst[0] = 0u; xst[1] = 0u; (void)xb_add(&xbar[XB_XCNT(xb_xcc_id())], 1u); }
    }
    __syncthreads();
    const int lo = a.ph_lo, hi = a.ph_hi;
#define IN(k) (((PHMASK >> (k)) & 1) && (COOP || (lo <= (k) && (k) < hi)))
#ifndef CG_SEAM
#define CG_SEAM 0
#endif
#define SEAM(k) do { if constexpr (COOP) { if (IN(k) && IN((k) + 1)) { if ((k) == CG_SEAM) cg::this_grid().sync(); else xcd_barrier(xbar, xst, lane_id_fresh() == 0 && wave0 == 0); } } } while (0)

    if (IN(0)) REP(0) { const Ptrs P = mkptrs(ptab); p0_prologue(P, lds, vcu, G, fresh_tid()); }
    SEAM(0);
    if (IN(1)) REP(1) { const Ptrs P = mkptrs(ptab);
#ifndef NO_G1A
        { pg8::Gemm g{P.U, P.W1T, T, 16384, D, D}; pg8::StaticOrder S; S.init(T, 16384, G, bx);
          pg8::EpiG1 E{P.PA, P.PP, P.PGG};
          pg8::gemm_phase<pg8::EpiG1, pg8::StaticOrder, false>(lds, g, S, E, fresh_tid()); }
#endif
#ifndef NO_G1B
        { pg8::Gemm g{P.U8, P.W8T, T, 8192, D / 2, D / 2}; pg8::StaticOrder S; S.init(T, 8192, G, bx);
          pg8::EpiGate E{P.PG, P.gate_bias};
          pg8::gemm_phase<pg8::EpiGate, pg8::StaticOrder, true>(lds, g, S, E, fresh_tid()); }
#endif
    }
    SEAM(1);
    if (IN(2)) REP(2) { const Ptrs P = mkptrs(ptab);
        h1_phase(P, lds, bx, G, fresh_tid());
        __syncthreads();
        yb_phase(P, G, fresh_tid());
    }
    SEAM(2);
    if (IN(3)) REP(3) { const Ptrs P = mkptrs(ptab); h2_phase(P, G, fresh_tid()); }
    SEAM(3);
    if (IN(4)) REP(4) { const Ptrs P = mkptrs(ptab);
        h3_phase(P, lds, bx, G, fresh_tid());
        __syncthreads();
    }
    SEAM(4);
    if (IN(5)) REP(5) { const Ptrs P = mkptrs(ptab);
        pg8::Gemm g{P.YAB, P.WABT, T, D, 4096, HW}; pg8::StaticOrder S; S.init(T, D, G, bx, 2, 4);
        pg8::EpiG2 E{P.PG, P.MG};
        pg8::gemm_phase(lds, g, S, E, fresh_tid());
    }
    SEAM(5);
    if (IN(6)) { const Ptrs P = mkptrs(ptab);
        pg8::Gemm g{P.MG, P.WOT, T, D, D, D}; pg8::StaticOrder S; S.init(T, D, G, bx, 1, 4);
        pg8::EpiG3 E{P.x, P.U, P.ssq, P.cnt};
        pg8::gemm_phase(lds, g, S, E, fresh_tid());
        if constexpr (COOP) {
            const int tid = fresh_tid(); pg8::Unit u;
            for (int ui = 0; S.next(ui, u); ++ui) pg8::final_tile(u, P.U, P.ssq, P.cnt, P.final_nw, P.out, tid);
        }
    }
    if constexpr (!COOP) { if (IN(7)) { const Ptrs P = mkptrs(ptab); final_phase(P, G, fresh_tid()); } }
#undef IN
#undef SEAM
}

extern "C" void kernel_launch(void* const* d_in, const int* in_sizes, int n_in, void* d_out, int out_size, void* d_ws, size_t ws_size, hipStream_t stream) {
    static int grid = 0;
    if (grid == 0) {
        if (n_in != 11 || in_sizes[0] != T * D || out_size != T * D || ws_size < WS_END) { fprintf(stderr, "kernel_launch: unexpected shapes / workspace (n_in %d, ws %zu, need %zu)\n", n_in, ws_size, (size_t)WS_END); grid = -1; return; }
        int dev = 0, cus = 0, per_cu = 0;
        (void)hipGetDevice(&dev); (void)hipDeviceGetAttribute(&cus, hipDeviceAttributeMultiprocessorCount, dev);
        constexpr int KCOOP = (N_LAUNCHES == 1) ? 1 : 0;
        (void)hipFuncSetAttribute((const void*)mega<KCOOP>, hipFuncAttributeMaxDynamicSharedMemorySize, LDS_BYTES);
        if (hipOccupancyMaxActiveBlocksPerMultiprocessor(&per_cu, (const void*)mega<KCOOP>, 512, LDS_BYTES) != hipSuccess || per_cu < 1) { fprintf(stderr, "kernel_launch: occupancy query failed (%d)\n", per_cu); (void)hipGetLastError(); grid = -1; return; }
        grid = cus * 1;
        if (grid <= 0) grid = 256;
    }
    if (grid < 0) return;
    Args a{};
    for (int i = 0; i < 11; ++i) a.in[i] = (const float*)d_in[i];
    a.out = (float*)d_out; a.ws = (unsigned char*)d_ws;
#if N_LAUNCHES == 1
    (void)hipMemsetAsync((char*)d_ws + WS_BAR, 0, 16384 + 32 * 256, stream);
    a.ph_lo = 0; a.ph_hi = NPH;
    void* args[] = {&a};
    hipError_t e = hipLaunchCooperativeKernel((const void*)mega<1>, dim3(grid), dim3(512), args, LDS_BYTES, stream);
    if (e != hipSuccess) fprintf(stderr, "cooperative launch failed: %s (grid %d)\n", hipGetErrorString(e), grid);
#else
    for (int p = 0; p < NPH; ++p) { a.ph_lo = p; a.ph_hi = p + 1; hipLaunchKernelGGL(mega<0>, dim3(grid), dim3(512), LDS_BYTES, stream, a); }
#endif
}
```
